# Optimizing an MI355X kernel written in HIP

```python
import math
import jax, jax.numpy as jnp
from jax import lax
import numpy as np

D_MODEL = 1024
BATCH = 4
SEQ = 8192
DEPTH = 1

PLE_DIM = 256
GLA_HEADS = 4
GLA_DK = D_MODEL // 2 // GLA_HEADS
GLA_DV = D_MODEL // GLA_HEADS
GLA_GATE_RANK = 16
GLA_GATE_TEMP = 16.0
GLA_CHUNK = 64
DSA_HEADS = 16
DSA_HEAD_DIM = D_MODEL // DSA_HEADS
DSA_LATENT = 128
IDX_HEADS = 8
IDX_DIM = 64
TOPK_MAX = 256
Q_BLOCK = 128
D_FF = 2816
CONV_W = 3
LN_EPS = 1e-5
DEEPNORM_ALPHA = (2.0 * DEPTH) ** 0.25
DEEPNORM_BETA = (8.0 * DEPTH) ** -0.25
SPLIT_SIZES = (
    GLA_HEADS * GLA_DK,
    GLA_HEADS * GLA_DK,
    GLA_HEADS * GLA_DV,
    GLA_HEADS * GLA_DV,
    GLA_GATE_RANK,
    DSA_HEADS * DSA_LATENT,
    DSA_LATENT,
    IDX_HEADS * IDX_DIM,
    IDX_DIM,
    IDX_HEADS,
    2 * D_MODEL,
)
IN_COLS = sum(SPLIT_SIZES)

kernel_name = 'hybrid_gla_dsa_convffn_block'


def _split_points():
    return [int(v) for v in np.cumsum(np.array(SPLIT_SIZES))[:-1]]


def layer_norm(x, g, b):
    xf = x.astype(jnp.float32)
    mu = jnp.mean(xf, axis=-1, keepdims=True)
    var = jnp.mean(jnp.square(xf - mu), axis=-1, keepdims=True)
    return ((xf - mu) * lax.rsqrt(var + LN_EPS) * g.astype(jnp.float32) + b.astype(jnp.float32)).astype(x.dtype)


def rms_norm(x, g):
    xf = x.astype(jnp.float32)
    ms = jnp.mean(jnp.square(xf), axis=-1, keepdims=True)
    return (xf * lax.rsqrt(ms + LN_EPS) * g.astype(jnp.float32)).astype(x.dtype)


def gla_chunked(q, k, v, log_a):
    q, k, v, log_a = (t.astype(jnp.float32) for t in (q, k, v, log_a))
    B, L, H, dk = q.shape
    dv = v.shape[-1]
    C = GLA_CHUNK
    N = L // C

    def to_chunks(t):
        return t.reshape(B, N, C, H, t.shape[-1]).transpose(1, 0, 3, 2, 4)

    qc, kc, vc, ac = (to_chunks(t) for t in (q, k, v, log_a))
    b = jnp.cumsum(ac, axis=3)
    b_last = b[:, :, :, -1:, :]
    q_in = qc * jnp.exp(b)
    k_in = kc * jnp.exp(-b)
    k_state = kc * jnp.exp(b_last - b)
    causal = jnp.tril(jnp.ones((C, C), dtype=bool))
    attn = jnp.where(causal, jnp.einsum('nbhid,nbhjd->nbhij', q_in, k_in), 0.0)
    o_intra = jnp.einsum('nbhij,nbhjv->nbhiv', attn, vc)

    def step(S, xs):
        q_i, k_i, v_i, decay_i = xs
        o = jnp.einsum('bhid,bhdv->bhiv', q_i, S)
        S = S * decay_i[:, :, 0, :, None] + jnp.einsum('bhjd,bhjv->bhdv', k_i, v_i)
        return S, o

    S0 = jnp.zeros((B, H, dk, dv), jnp.float32)
    _, o_inter = lax.scan(step, S0, (q_in, k_state, vc, jnp.exp(b_last)))
    o = o_intra + o_inter
    return o.transpose(1, 0, 3, 2, 4).reshape(B, L, H, dv)


def dsa_attention(q, ckv, iq, ik, iw):
    B, L, H, dc = q.shape
    top_k = min(TOPK_MAX, L // 4)
    nb = L // Q_BLOCK
    key_pos = jnp.arange(L, dtype=jnp.int32)

    def blockify(t):
        return jnp.swapaxes(t.reshape((B, nb, Q_BLOCK) + t.shape[2:]), 0, 1)

    def one_block(args):
        q_b, iq_b, iw_b, q_pos = args
        s = jax.nn.relu(jnp.einsum('bqhd,bsd->bqhs', iq_b, ik).astype(jnp.float32))
        score = jnp.einsum('bqh,bqhs->bqs', iw_b.astype(jnp.float32), s)
        causal = key_pos[None, :] <= q_pos[:, None]
        score = jnp.where(causal[None], score, -jnp.inf)
        _, idx = lax.top_k(score, top_k)
        valid = idx <= q_pos[None, :, None]
        kv_sel = jax.vmap(lambda c, i: c[i])(ckv, idx)
        logits = jnp.einsum('bqhc,bqkc->bqhk', q_b, kv_sel).astype(jnp.float32) * (dc ** -0.5)
        logits = jnp.where(valid[:, :, None, :], logits, -jnp.inf)
        probs = jax.nn.softmax(logits, axis=-1).astype(kv_sel.dtype)
        return jnp.einsum('bqhk,bqkc->bqhc', probs, kv_sel)

    pos_blocks = jnp.arange(L, dtype=jnp.int32).reshape(nb, Q_BLOCK)
    out = lax.map(one_block, (blockify(q), blockify(iq), blockify(iw), pos_blocks))
    return jnp.swapaxes(out, 0, 1).reshape(B, L, H, dc)


def causal_dwconv(h, w, b):
    L = h.shape[1]
    hp = jnp.pad(h, ((0, 0), (CONV_W - 1, 0), (0, 0)))
    out = w[CONV_W - 1] * h
    for j in range(CONV_W - 1):
        out = out + w[j] * hp[:, j:j + L]
    return out + b


def setup_inputs(seed: int = 0) -> dict:
    key = jax.random.key(seed)
    ks = jax.random.split(key, 24)

    def nrm(k, shape, fan_in, scale=1.0):
        return jax.random.normal(k, shape, jnp.float32) * (scale * fan_in ** -0.5)

    def gain(k, shape):
        return 1.0 + 0.02 * jax.random.normal(k, shape, jnp.float32)

    def bias(k, shape, s=0.02):
        return s * jax.random.normal(k, shape, jnp.float32)

    return {
        'x': jax.random.normal(ks[0], (BATCH, SEQ, D_MODEL), jnp.float32),
        'p': jax.random.normal(ks[1], (DEPTH, BATCH, SEQ, PLE_DIM), jnp.float32),
        'w_in': nrm(ks[2], (DEPTH, D_MODEL, IN_COLS), D_MODEL),
        'w_gla_gate_up': nrm(ks[3], (DEPTH, GLA_GATE_RANK, GLA_HEADS * GLA_DK), GLA_GATE_RANK),
        'b_gla_gate': bias(ks[4], (DEPTH, GLA_HEADS * GLA_DK), 0.1),
        'g_gla_norm': gain(ks[5], (DEPTH, GLA_HEADS * GLA_DV)),
        'w_gla_proj': nrm(ks[6], (DEPTH, GLA_HEADS * GLA_DV, D_MODEL), GLA_HEADS * GLA_DV),
        'g_ckv_norm': gain(ks[7], (DEPTH, DSA_LATENT)),
        'w_uv': nrm(ks[8], (DEPTH, DSA_HEADS, DSA_LATENT, DSA_HEAD_DIM), DSA_LATENT),
        'w_dsa_proj': nrm(ks[9], (DEPTH, DSA_HEADS * DSA_HEAD_DIM, D_MODEL), DSA_HEADS * DSA_HEAD_DIM),
        'w_out': nrm(ks[10], (DEPTH, D_MODEL, D_MODEL), D_MODEL, DEEPNORM_BETA),
        'ln1_g': gain(ks[11], (DEPTH, D_MODEL)),
        'ln1_b': bias(ks[12], (DEPTH, D_MODEL)),
        'w_up': nrm(ks[13], (DEPTH, D_MODEL, 2 * D_FF), D_MODEL),
        'conv_w': nrm(ks[14], (DEPTH, CONV_W, 2 * D_FF), CONV_W),
        'conv_b': bias(ks[15], (DEPTH, 2 * D_FF)),
        'w_down': nrm(ks[16], (DEPTH, D_FF, D_MODEL), D_FF, DEEPNORM_BETA),
        'ln2_g': gain(ks[17], (DEPTH, D_MODEL)),
        'ln2_b': bias(ks[18], (DEPTH, D_MODEL)),
        'w_ple': nrm(ks[19], (DEPTH, PLE_DIM, D_MODEL), PLE_DIM, DEEPNORM_BETA),
        'w_ple_gate': nrm(ks[20], (DEPTH, D_MODEL, D_MODEL), D_MODEL),
        'ln3_g': gain(ks[21], (DEPTH, D_MODEL)),
        'ln3_b': bias(ks[22], (DEPTH, D_MODEL)),
    }


def reference(x, p, w_in, w_gla_gate_up, b_gla_gate, g_gla_norm, w_gla_proj, g_ckv_norm, w_uv,
              w_dsa_proj, w_out, ln1_g, ln1_b, w_up, conv_w, conv_b, w_down, ln2_g, ln2_b,
              w_ple, w_ple_gate, ln3_g, ln3_b):
    B, L, _ = x.shape
    for i in range(DEPTH):
        proj = x @ w_in[i]
        gq, gk, gv, gr, ga, dq, ckv, iq, ik, iw, gates = jnp.split(proj, _split_points(), axis=-1)

        q_a = gq.reshape(B, L, GLA_HEADS, GLA_DK) * (GLA_DK ** -0.5)
        k_a = gk.reshape(B, L, GLA_HEADS, GLA_DK)
        v_a = gv.reshape(B, L, GLA_HEADS, GLA_DV)
        z = (ga @ w_gla_gate_up[i] + b_gla_gate[i]).astype(jnp.float32)
        log_a = (jax.nn.log_sigmoid(z) / GLA_GATE_TEMP).reshape(B, L, GLA_HEADS, GLA_DK)
        o_a = gla_chunked(q_a, k_a, v_a, log_a)
        o_a = rms_norm(o_a, g_gla_norm[i].reshape(GLA_HEADS, GLA_DV))
        o_a = o_a.reshape(B, L, GLA_HEADS * GLA_DV).astype(x.dtype) * jax.nn.silu(gr)
        y_a = o_a @ w_gla_proj[i]

        q_b = dq.reshape(B, L, DSA_HEADS, DSA_LATENT)
        c_kv = rms_norm(ckv, g_ckv_norm[i])
        iq_b = iq.reshape(B, L, IDX_HEADS, IDX_DIM)
        iw_b = iw * ((IDX_HEADS ** -0.5) * (IDX_DIM ** -0.5))
        o_b = dsa_attention(q_b, c_kv, iq_b, ik, iw_b)
        o_b = jnp.einsum('blhc,hcd->blhd', o_b, w_uv[i]).reshape(B, L, DSA_HEADS * DSA_HEAD_DIM)
        y_b = o_b @ w_dsa_proj[i]

        gate_a, gate_b = jnp.split(gates, 2, axis=-1)
        mixed = (jax.nn.sigmoid(gate_a) * y_a + jax.nn.sigmoid(gate_b) * y_b) @ w_out[i]
        x = layer_norm(DEEPNORM_ALPHA * x + mixed, ln1_g[i], ln1_b[i])

        h = causal_dwconv(x @ w_up[i], conv_w[i], conv_b[i])
        h_gate, h_val = jnp.split(h, 2, axis=-1)
        ffn = (jax.nn.silu(h_gate) * h_val) @ w_down[i]
        x = layer_norm(DEEPNORM_ALPHA * x + ffn, ln2_g[i], ln2_b[i])

        ple = jax.nn.sigmoid(x @ w_ple_gate[i]) * (p[i] @ w_ple[i])
        x = layer_norm(DEEPNORM_ALPHA * x + ple, ln3_g[i], ln3_b[i])
    return x
```

```cpp
#include <hip/hip_runtime.h>
#include <hip/hip_cooperative_groups.h>
#include <cstdio>
namespace cg = cooperative_groups;

#ifndef MULTI_LAUNCH
#define MULTI_LAUNCH 0
#endif
#ifndef PROBE_SEL_REP
#define PROBE_SEL_REP 0
#endif
#ifndef PROBE_GLA_REP
#define PROBE_GLA_REP 0
#endif
#ifndef PROBE_SEQ
#define PROBE_SEQ {0,1,2,3,4,5,6,7,9,10,11,12,13}
#endif

#define LAS __attribute__((address_space(3)))
typedef _Float16 h16;
typedef _Float16 h16x2 __attribute__((ext_vector_type(2)));
typedef _Float16 h16x4 __attribute__((ext_vector_type(4)));
typedef _Float16 h16x8 __attribute__((ext_vector_type(8)));
typedef float f32x2 __attribute__((ext_vector_type(2)));
typedef float f32x4 __attribute__((ext_vector_type(4)));
typedef float f32x16 __attribute__((ext_vector_type(16)));
typedef unsigned u32x2 __attribute__((ext_vector_type(2)));
typedef unsigned u32x4 __attribute__((ext_vector_type(4)));
typedef short v4s __attribute__((__vector_size__(8)));

constexpr int T_ = 32768, L_ = 8192;
constexpr float ALPHA = 1.189207115002721f;
constexpr float LN_EPS = 1e-5f;
constexpr size_t MiB = (size_t)1 << 20;
constexpr int NPHASE = 14;
constexpr int SMEM_BYTES = 163840;

constexpr size_t OFF_WIN = 0;
constexpr size_t OFF_WUP = OFF_WIN + (size_t)7936 * 1024 * 2;
constexpr size_t OFF_WDOWN = OFF_WUP + (size_t)5632 * 1024 * 2;
constexpr size_t OFF_WGLA = OFF_WDOWN + (size_t)1024 * 2816 * 2;
constexpr size_t OFF_WCOMB = OFF_WGLA + (size_t)1024 * 1024 * 2;
constexpr size_t OFF_WOUT = OFF_WCOMB + (size_t)1024 * 2048 * 2;
constexpr size_t OFF_WPG = OFF_WOUT + (size_t)1024 * 1024 * 2;
constexpr size_t OFF_WPLE = OFF_WPG + (size_t)1024 * 1024 * 2;
constexpr size_t OFF_X16 = 44 * MiB;
constexpr size_t OFF_PROJ = 108 * MiB;
constexpr size_t OFF_GQ = OFF_PROJ;
constexpr size_t OFF_GK = OFF_PROJ + 32 * MiB;
constexpr size_t OFF_GV = OFF_PROJ + 64 * MiB;
constexpr size_t OFF_GR = OFF_PROJ + 128 * MiB;
constexpr size_t OFF_DQ = OFF_PROJ + 192 * MiB;
constexpr size_t OFF_MISC = OFF_PROJ + 320 * MiB;
constexpr size_t OFF_IQ = OFF_PROJ + 336 * MiB;
constexpr size_t OFF_MERGED = OFF_PROJ;
constexpr size_t OFF_P16 = OFF_PROJ + 352 * MiB;
constexpr size_t OFF_H = OFF_PROJ;
constexpr size_t OFF_G = OFF_PROJ;
constexpr size_t OFF_ATTN = 476 * MiB;
constexpr size_t OFF_DECAY = 492 * MiB;
constexpr size_t OFF_HALO = 493 * MiB;
constexpr size_t OFF_CTR = 43 * MiB;
constexpr size_t OFF_CKVC = 493 * MiB;
constexpr size_t OFF_IKC = 501 * MiB;
constexpr size_t WS_NEED = 505 * MiB;

struct Params {
    const float *x, *p, *w_in, *w_gate_up, *b_gate, *g_gla, *w_gla_proj, *g_ckv, *w_uv, *w_dsa_proj, *w_out, *ln1_g, *ln1_b,
        *w_up, *conv_w, *conv_b, *w_down, *ln2_g, *ln2_b, *w_ple, *w_ple_gate, *ln3_g, *ln3_b;
    float* out;
    unsigned char* ws;
    int phase_lo, phase_hi, pad0, pad1;
};

__device__ __forceinline__ float sigmoidf_(float x) { return 1.0f / (1.0f + __expf(-x)); }
__device__ __forceinline__ float siluf_(float x) { return x / (1.0f + __expf(-x)); }
__device__ __forceinline__ h16x8 pack8(f32x4 a, f32x4 b) {
    h16x8 r; r[0] = (h16)a[0]; r[1] = (h16)a[1]; r[2] = (h16)a[2]; r[3] = (h16)a[3]; r[4] = (h16)b[0]; r[5] = (h16)b[1]; r[6] = (h16)b[2]; r[7] = (h16)b[3]; return r;
}

namespace gm {
constexpr int BM = 256, BK = 64, HALF = 128, HTB = HALF * BK * 2, NXCD = 8, WGM = 8;
__device__ __forceinline__ int lds_byte(int r, int c) { const int st = (r >> 4) * 2 + (c >> 5), rr = r & 15, cc = c & 31, ob = rr * 64 + cc * 2; return st * 1024 + (ob ^ (((ob >> 9) & 1) << 5)); }
__device__ __forceinline__ void stage_rc(int b, int& R, int& C) { const int st = b / 1024, sb = b % 1024, swz = sb ^ (((sb >> 9) & 1) << 5); R = (st >> 1) * 16 + swz / 64; C = (st & 1) * 32 + (swz % 64) / 2; }
__device__ __forceinline__ int perm32(int rho) { const int n = rho >> 4, i = rho & 15; return 8 * (i >> 2) + 4 * n + (i & 3); }
struct Unit { int pm, pn; };
struct Gemm { const h16* A; const h16* Bt; int M, N, K, lda; };
struct StaticOrder {
    int nM, nN, nwg, G, c;
    __device__ void init(int M, int N, int G_, int c_) { nM = M / BM; nN = N / BM; nwg = nM * nN; G = G_; c = c_; }
    __device__ bool next(int i, Unit& u) const {
        const long Lx = (long)i * G + c; if (Lx >= nwg) return false;
        int wgid = (int)Lx; { const int q = nwg / NXCD, r = nwg % NXCD, xcd = wgid % NXCD, off = wgid / NXCD; wgid = (xcd < r ? xcd * (q + 1) : r * (q + 1) + (xcd - r) * q) + off; }
        const int nig = WGM * nN, gid = wgid / nig, fm = gid * WGM, gsz = (nM - fm) < WGM ? (nM - fm) : WGM;
        u.pm = fm + ((wgid % nig) % gsz); u.pn = (wgid % nig) / gsz; return true;
    }
};

template <int MODE> struct Epi {
    static constexpr bool PERM = (MODE == 0 || MODE == 1 || MODE == 2 || MODE == 4 || MODE == 6);
    void* o; const void* a1; const void* a2; int ldc; unsigned char* ws;
    __device__ __forceinline__ void operator()(const f32x4 (&acc)[2][2][4][2], const Unit& u, int wr, int wc, int fr, int fq) const {
        const int row0 = u.pm * BM + wr * 64 + fr;
        if constexpr (PERM) {
            int colt = u.pn * BM; h16* base = (h16*)o; int ld = ldc; bool sig = (MODE == 6);
            if constexpr (MODE == 0) {
                const int pn = u.pn;
                if (pn < 2) { base = (h16*)(ws + OFF_GQ); ld = 512; colt = pn * 256; }
                else if (pn < 4) { base = (h16*)(ws + OFF_GK); ld = 512; colt = (pn - 2) * 256; }
                else if (pn < 8) { base = (h16*)(ws + OFF_GV) + (size_t)(pn - 4) * T_ * 256; ld = 256; colt = 0; }
                else if (pn < 12) { base = (h16*)(ws + OFF_GR); ld = 1024; colt = (pn - 8) * 256; }
                else if (pn < 20) { base = (h16*)(ws + OFF_DQ); ld = 2048; colt = (pn - 12) * 256; }
                else if (pn == 20) { base = (h16*)(ws + OFF_MISC); ld = 256; colt = 0; }
                else if (pn < 23) { base = (h16*)(ws + OFF_IQ); ld = 512; colt = (pn - 21) * 256; }
                else { base = (h16*)o; ld = 2048; colt = (pn - 23) * 256; sig = true; }
            }
            const int col0 = colt + wc * 32 + 8 * fq;
            h16x8 sgv[2][2], pvv[2][2];
            auto ldm = [&](int gi, int slot) {
                if constexpr (MODE == 1 || MODE == 2) {
                    const int row = row0 + (gi >> 2) * HALF + (gi & 3) * 16;
#pragma unroll
                    for (int bj = 0; bj < 2; ++bj) {
                        sgv[slot][bj] = *(const h16x8*)((const h16*)a1 + (size_t)row * 2048 + (MODE == 2 ? 1024 : 0) + col0 + bj * HALF);
                        if constexpr (MODE == 2) pvv[slot][bj] = *(const h16x8*)(base + (size_t)row * ld + col0 + bj * HALF);
                    }
                }
            };
            ldm(0, 0);
#pragma unroll
            for (int gi = 0; gi < 8; ++gi) {
                const int slot = gi & 1, ai = gi >> 2, m = gi & 3;
                if (gi < 7) ldm(gi + 1, slot ^ 1);
                {
                    const int row = row0 + ai * HALF + m * 16;
                    h16* rowp = base + (size_t)row * ld + col0;
#pragma unroll
                    for (int bj = 0; bj < 2; ++bj) {
                        f32x4 v0 = acc[ai][bj][m][0], v1 = acc[ai][bj][m][1];
                        if (sig) {
#pragma unroll
                            for (int j = 0; j < 4; ++j) { v0[j] = sigmoidf_(v0[j]); v1[j] = sigmoidf_(v1[j]); }
                        }
                        if constexpr (MODE == 1 || MODE == 2) {
                            const h16x8 sg = sgv[slot][bj];
#pragma unroll
                            for (int j = 0; j < 4; ++j) { v0[j] *= (float)sg[j]; v1[j] *= (float)sg[4 + j]; }
                            if constexpr (MODE == 2) {
                                const h16x8 pv = pvv[slot][bj];
#pragma unroll
                                for (int j = 0; j < 4; ++j) { v0[j] += (float)pv[j]; v1[j] += (float)pv[4 + j]; }
                            }
                        }
                        *(h16x8*)(rowp + bj * HALF) = pack8(v0, v1);
                        if constexpr (MODE == 4) {
                            if (wr == 1 && m == 3 && fr >= 14 && (row >> 7) + 1 < 256)
                                *(h16x8*)((h16*)(ws + OFF_HALO) + ((size_t)((row >> 7) + 1) * 2 + (fr - 14)) * 5632 + col0 + bj * HALF) = pack8(v0, v1);
                        }
                    }
                    asm volatile("" ::: "memory");
                }
            }
        } else {
            const int col0 = u.pn * BM + wc * 32 + 4 * fq;
            f32x4 bs[2][4]; h16x4 gg[2][4];
            auto ld = [&](int gi, int slot) {
                const int row = row0 + (gi >> 2) * HALF + (gi & 3) * 16; const size_t off = (size_t)row * 1024 + col0;
#pragma unroll
                for (int q = 0; q < 4; ++q) {
                    const size_t o2 = off + (q >> 1) * HALF + (q & 1) * 16;
                    if constexpr (MODE == 3) bs[slot][q] = *(const f32x4*)((const float*)a1 + o2);
                    else { const h16x4 hb = *(const h16x4*)((const h16*)a1 + o2); bs[slot][q] = (f32x4){(float)hb[0], (float)hb[1], (float)hb[2], (float)hb[3]}; }
                    if constexpr (MODE == 7) gg[slot][q] = *(const h16x4*)((const h16*)a2 + o2);
                }
            };
            ld(0, 0);
#pragma unroll
            for (int gi = 0; gi < 8; ++gi) {
                const int slot = gi & 1;
                if (gi < 7) ld(gi + 1, slot ^ 1);
                const int ai = gi >> 2, m = gi & 3;
                const int row = row0 + ai * HALF + m * 16; const size_t off = (size_t)row * 1024 + col0;
#pragma unroll
                for (int q = 0; q < 4; ++q) {
                    const int bj = q >> 1, n = q & 1; const size_t o2 = off + bj * HALF + n * 16;
                    f32x4 v = acc[ai][bj][m][n];
                    if constexpr (MODE == 7) { v[0] *= (float)gg[slot][q][0]; v[1] *= (float)gg[slot][q][1]; v[2] *= (float)gg[slot][q][2]; v[3] *= (float)gg[slot][q][3]; }
                    const f32x4 rv = bs[slot][q] * ALPHA + v;
                    if constexpr (MODE == 7) *(f32x4*)((float*)o + o2) = rv;
                    else { h16x4 hv; hv[0] = (h16)rv[0]; hv[1] = (h16)rv[1]; hv[2] = (h16)rv[2]; hv[3] = (h16)rv[3]; *(h16x4*)((h16*)o + o2) = hv; }
                }
                asm volatile("" ::: "memory");
            }
        }
    }
};

template <class EpiT>
__device__ __forceinline__ void gemm_phase(LAS unsigned char* lds, const Gemm g, const StaticOrder& S, const EpiT& E) {
    const int tid = threadIdx.x, wid = __builtin_amdgcn_readfirstlane(tid >> 6), lane = tid & 63, wr = wid >> 2, wc = wid & 3, fr = lane & 15, fq = lane >> 4;
    const int K = g.K, nt = K / BK, lda = g.lda;
    unsigned voffA[2], voffB[2];
#pragma unroll
    for (int i = 0; i < 2; ++i) { int R, C; stage_rc(tid * 16 + i * 8192, R, C); const int Rb = EpiT::PERM ? ((R & ~31) + perm32(R & 31)) : R;
        voffA[i] = (unsigned)(R * lda + C) * 2u; voffB[i] = (unsigned)(Rb * K + C) * 2u; }
    const size_t kstep = (size_t)(BK * 2);
    const size_t hstepA = (size_t)HALF * lda * 2, hstepB = (size_t)HALF * K * 2;
    const size_t tstepA = 2 * hstepA, tstepB = 2 * hstepB;
    const unsigned ldsw = (unsigned)wid * 1024u;
    const int aoff = lds_byte(wr * 64 + fr, fq * 8), boff = lds_byte(wc * 32 + fr, fq * 8);
#define PG8_SA(b, h) (((b) * 2 + (h)) * HTB)
#define PG8_SB(b, h) ((4 + (b) * 2 + (h)) * HTB)
#define PG8_STAGE(bufoff, gbase, voff) do { _Pragma("unroll") for (int _i = 0; _i < 2; ++_i) \
        __builtin_amdgcn_global_load_lds((const unsigned*)((const char*)(gbase) + (voff)[_i]), (LAS unsigned*)(lds + (bufoff) + ldsw + _i * 8192), 16, 0, 0); } while (0)
#define PG8_LDA(dst, b, h) do { _Pragma("unroll") for (int m = 0; m < 4; ++m) _Pragma("unroll") for (int k = 0; k < 2; ++k) dst[m][k] = *(const LAS h16x8*)(lds + PG8_SA(b, h) + aoff + m * 2048 + k * 1024); } while (0)
#define PG8_LDB(dst, b, h) do { _Pragma("unroll") for (int n = 0; n < 2; ++n) _Pragma("unroll") for (int k = 0; k < 2; ++k) dst[n][k] = *(const LAS h16x8*)(lds + PG8_SB(b, h) + boff + n * 2048 + k * 1024); } while (0)
#define PG8_MMA(ai, bj, At, Bt) do { __builtin_amdgcn_s_setprio(1); _Pragma("unroll") for (int m = 0; m < 4; ++m) _Pragma("unroll") for (int n = 0; n < 2; ++n) _Pragma("unroll") for (int k = 0; k < 2; ++k) \
        acc[ai][bj][m][n] = __builtin_amdgcn_mfma_f32_16x16x32_f16(Bt[n][k], At[m][k], acc[ai][bj][m][n], 0, 0, 0); __builtin_amdgcn_s_setprio(0); } while (0)
#define PG8_WAIT_V(n) asm volatile("s_waitcnt vmcnt(" #n ")" ::: "memory")
#define PG8_WAIT_L(n) asm volatile("s_waitcnt lgkmcnt(" #n ")" ::: "memory")
#define PG8_BAR __builtin_amdgcn_s_barrier()
#define PG8_SCHED __builtin_amdgcn_sched_barrier(0)
    Unit cur, nxt; int ui = 0;
    if (!S.next(0, cur)) return;
    f32x4 acc[2][2][4][2];
#pragma unroll
    for (int a = 0; a < 2; ++a)
#pragma unroll
        for (int b = 0; b < 2; ++b)
#pragma unroll
            for (int m = 0; m < 4; ++m)
#pragma unroll
                for (int n = 0; n < 2; ++n) acc[a][b][m][n] = (f32x4){0.f, 0.f, 0.f, 0.f};
    h16x8 At[4][2], B0[2][2], B1[2][2];
    const char* cA = (const char*)g.A + (size_t)cur.pm * tstepA; const char* cB = (const char*)g.Bt + (size_t)cur.pn * tstepB;
    PG8_STAGE(PG8_SB(0, 0), cB, voffB); PG8_STAGE(PG8_SA(0, 0), cA, voffA); PG8_STAGE(PG8_SB(0, 1), cB + hstepB, voffB); PG8_STAGE(PG8_SA(0, 1), cA + hstepA, voffA);
    if (wr == 1) PG8_BAR;
    PG8_WAIT_V(4); PG8_BAR;
    PG8_STAGE(PG8_SB(1, 0), cB + kstep, voffB); PG8_STAGE(PG8_SA(1, 0), cA + kstep, voffA); PG8_STAGE(PG8_SB(1, 1), cB + hstepB + kstep, voffB);
    PG8_WAIT_V(6); PG8_BAR;
    for (;;) {
        const bool has_next = S.next(ui + 1, nxt);
        const char* nA = has_next ? (const char*)g.A + (size_t)nxt.pm * tstepA : cA; const char* nB = has_next ? (const char*)g.Bt + (size_t)nxt.pn * tstepB : cB;
        for (int t = 0; t < nt; t += 2) {
            const bool last = (t == nt - 2);
            const char* a1 = cA + (size_t)(t + 1) * kstep;
            const char* a2 = last ? nA : cA + (size_t)(t + 2) * kstep; const char* b2 = last ? nB : cB + (size_t)(t + 2) * kstep;
            const char* a3 = a2 + kstep; const char* b3 = b2 + kstep;
            PG8_LDB(B0, 0, 0); PG8_SCHED; PG8_LDA(At, 0, 0); PG8_STAGE(PG8_SA(1, 1), a1 + hstepA, voffA);
            PG8_WAIT_L(8); PG8_BAR; PG8_WAIT_L(0); PG8_MMA(0, 0, At, B0); PG8_BAR; PG8_SCHED;
            PG8_LDB(B1, 0, 1); PG8_STAGE(PG8_SB(0, 0), b2, voffB);
            PG8_BAR; PG8_WAIT_L(0); PG8_MMA(0, 1, At, B1); PG8_BAR;
            PG8_LDA(At, 0, 1); PG8_STAGE(PG8_SA(0, 0), a2, voffA);
            PG8_BAR; PG8_WAIT_L(0); PG8_MMA(1, 0, At, B0); PG8_BAR; PG8_SCHED;
            PG8_STAGE(PG8_SB(0, 1), b2 + hstepB, voffB);
            PG8_WAIT_V(6); PG8_BAR; PG8_MMA(1, 1, At, B1); PG8_BAR;
            PG8_LDB(B0, 1, 0); PG8_SCHED; PG8_LDA(At, 1, 0); PG8_STAGE(PG8_SA(0, 1), a2 + hstepA, voffA);
            PG8_WAIT_L(8); PG8_BAR; PG8_WAIT_L(0); PG8_MMA(0, 0, At, B0); PG8_BAR; PG8_SCHED;
            PG8_LDB(B1, 1, 1); PG8_STAGE(PG8_SB(1, 0), b3, voffB);
            PG8_BAR; PG8_WAIT_L(0); PG8_MMA(0, 1, At, B1); PG8_BAR;
            PG8_LDA(At, 1, 1); PG8_STAGE(PG8_SA(1, 0), a3, voffA);
            PG8_BAR; PG8_WAIT_L(0); PG8_MMA(1, 0, At, B0); PG8_BAR; PG8_SCHED;
            PG8_STAGE(PG8_SB(1, 1), b3 + hstepB, voffB);
            PG8_WAIT_V(6); PG8_BAR; PG8_MMA(1, 1, At, B1); PG8_BAR;
        }
        E(acc, cur, wr, wc, fr, fq);
        if (!has_next) break;
#pragma unroll
        for (int a = 0; a < 2; ++a)
#pragma unroll
            for (int b = 0; b < 2; ++b)
#pragma unroll
                for (int m = 0; m < 4; ++m)
#pragma unroll
                    for (int n = 0; n < 2; ++n) acc[a][b][m][n] = (f32x4){0.f, 0.f, 0.f, 0.f};
        cur = nxt; cA = nA; cB = nB; ++ui;
    }
    PG8_WAIT_V(0);
    if (wr == 0) PG8_BAR;
    PG8_BAR;
#undef PG8_SA
#undef PG8_SB
#undef PG8_STAGE
#undef PG8_LDA
#undef PG8_LDB
#undef PG8_MMA
#undef PG8_WAIT_V
#undef PG8_WAIT_L
#undef PG8_BAR
#undef PG8_SCHED
}

template <int MODE>
__device__ void run_gemm(unsigned char* smem, const h16* A, int lda, const h16* Bt, int M, int N, int K, void* o, const void* a1, const void* a2, int ldc, unsigned char* ws) {
    Gemm g; g.A = A; g.Bt = Bt; g.M = M; g.N = N; g.K = K; g.lda = lda;
    StaticOrder S; S.init(M, N, (int)gridDim.x, (int)blockIdx.x);
    Epi<MODE> E; E.o = o; E.a1 = a1; E.a2 = a2; E.ldc = ldc; E.ws = ws;
    gemm_phase<Epi<MODE>>((LAS unsigned char*)smem, g, S, E);
    __syncthreads();
}
}

__device__ __forceinline__ int win_src(int n) {
    if (n < 3072) return n;
    if (n < 5120) return n - 3072 + 3088;
    if (n < 5248) return n - 5120 + 5136;
    if (n < 5312) return n - 5248 + 5776;
    if (n < 5328) return n - 5312 + 3072;
    if (n < 5336) return n - 5328 + 5840;
    if (n < 5376) return -1;
    if (n < 5888) return n - 5376 + 5264;
    return n - 5888 + 5848;
}

__device__ void cvt_f32_to_h16(const float* src, h16* dst, size_t n) {
    const size_t n8 = n / 8;
    for (size_t i = (size_t)blockIdx.x * blockDim.x + threadIdx.x; i < n8; i += (size_t)gridDim.x * blockDim.x) {
        const f32x4 a = ((const f32x4*)src)[2 * i], b = ((const f32x4*)src)[2 * i + 1];
        ((h16x8*)dst)[i] = pack8(a, b);
    }
}

__device__ void phase_prep(const Params& P, unsigned char* smem) {
    const int tid = threadIdx.x;
    if (blockIdx.x == 0 && tid < 64) ((unsigned*)(P.ws + OFF_CTR))[tid] = 0u;
    cvt_f32_to_h16(P.x, (h16*)(P.ws + OFF_X16), (size_t)T_ * 1024);
    float* tile = (float*)smem;
    for (int tix = blockIdx.x; tix < 5184; tix += gridDim.x) {
        const float* src; h16* dst; int ldsrc, K, tilesK, id; bool isin = false;
        if (tix < 1984) { src = P.w_in; ldsrc = 7896; K = 1024; dst = (h16*)(P.ws + OFF_WIN); id = tix; isin = true; }
        else if (tix < 3392) { src = P.w_up; ldsrc = 5632; K = 1024; dst = (h16*)(P.ws + OFF_WUP); id = tix - 1984; }
        else if (tix < 4096) { src = P.w_down; ldsrc = 1024; K = 2816; dst = (h16*)(P.ws + OFF_WDOWN); id = tix - 3392; }
        else if (tix < 4352) { src = P.w_gla_proj; ldsrc = 1024; K = 1024; dst = (h16*)(P.ws + OFF_WGLA); id = tix - 4096; }
        else if (tix < 4608) { src = P.w_out; ldsrc = 1024; K = 1024; dst = (h16*)(P.ws + OFF_WOUT); id = tix - 4352; }
        else if (tix < 4864) { src = P.w_ple_gate; ldsrc = 1024; K = 1024; dst = (h16*)(P.ws + OFF_WPG); id = tix - 4608; }
        else if (tix < 4928) { src = P.w_ple; ldsrc = 1024; K = 256; dst = (h16*)(P.ws + OFF_WPLE); id = tix - 4864; }
        else { src = P.w_dsa_proj; ldsrc = 1024; K = 1024; dst = (h16*)(P.ws + OFF_WCOMB); id = tix - 4928; }
        tilesK = K / 64;
        const int tn = id / tilesK, tk = id % tilesK;
        {
            const int n4 = tid & 15, n = tn * 64 + 4 * n4; const int sc = isin ? win_src(n) : n;
#pragma unroll
            for (int i = 0; i < 2; ++i) { const int kk = (tid >> 4) + 32 * i;
                f32x4 v = {0.f, 0.f, 0.f, 0.f};
                if (sc >= 0) v = *(const f32x4*)(src + (size_t)(tk * 64 + kk) * ldsrc + sc);
                *(f32x4*)&tile[kk * 68 + 4 * n4] = v; }
        }
        __syncthreads();
        {
            const int nn = tid >> 3, k8 = tid & 7;
            h16x8 o;
#pragma unroll
            for (int j = 0; j < 8; ++j) o[j] = (h16)tile[(8 * k8 + j) * 68 + nn];
            *(h16x8*)(dst + (size_t)(tn * 64 + nn) * K + tk * 64 + 8 * k8) = o;
        }
        __syncthreads();
    }
    h16* wu = (h16*)(P.ws + OFF_WCOMB + 2 * MiB);
    for (int e = blockIdx.x * blockDim.x + tid; e < 16 * 64 * 128; e += gridDim.x * blockDim.x) {
        const int h = e >> 13, d = (e >> 7) & 63, c = e & 127;
        wu[e] = (h16)P.w_uv[(size_t)(h * 128 + c) * 64 + d];
    }
}

__device__ void gla_prep_item(const Params& P, unsigned char* smem, int item) {
    const int tid = threadIdx.x, lane = tid & 63, w = __builtin_amdgcn_readfirstlane(tid >> 6);
    const int b = item >> 7, n = item & 127; const size_t tb = (size_t)b * L_ + 64 * n;
    h16* GQ = (h16*)(P.ws + OFF_GQ); h16* GK = (h16*)(P.ws + OFF_GK); h16* GV = (h16*)(P.ws + OFF_GV);
    const h16* MISC = (const h16*)(P.ws + OFF_MISC); h16* ATTN = (h16*)(P.ws + OFF_ATTN); float* DECAY = (float*)(P.ws + OFF_DECAY);
    h16* KS = (h16*)smem; float* LA = (float*)(smem + 65536); h16* QI = (h16*)(smem + 98304); h16* KI = (h16*)(smem + 115712);
    float* GA = (float*)(smem + 133120); float* TOT = (float*)(smem + 137216);
#pragma unroll
    for (int i = 0; i < 8; ++i) { const int idx = tid + 512 * i; ((u32x4*)KS)[idx] = ((const u32x4*)(GK + tb * 512))[idx]; }
#pragma unroll
    for (int i = 0; i < 2; ++i) { const int idx = tid + 512 * i; GA[idx] = (float)MISC[(tb + (idx >> 4)) * 256 + 192 + (idx & 15)]; }
    __syncthreads();
    const int d = tid & 127, tq = tid >> 7;
    float wg[16], wgn[16], bias, biasn;
#pragma unroll
    for (int r = 0; r < 16; ++r) wg[r] = P.w_gate_up[r * 512 + d];
    bias = P.b_gate[d];
    for (int h = 0; h < 4; ++h) {
        const int hc = h * 128 + d;
        {
            const int hn = (h < 3 ? h + 1 : 3) * 128 + d;
#pragma unroll
            for (int r = 0; r < 16; ++r) wgn[r] = P.w_gate_up[r * 512 + hn];
            biasn = P.b_gate[hn];
        }
        float run = 0.f;
        for (int tt = 0; tt < 16; ++tt) {
            const int t = 16 * tq + tt; float z = bias;
#pragma unroll
            for (int r = 0; r < 16; ++r) z += GA[t * 16 + r] * wg[r];
            const float ls = (fminf(z, 0.f) - __logf(1.0f + __expf(-fabsf(z)))) * 0.0625f;
            run += ls; LA[t * 128 + d] = run;
        }
        TOT[tq * 128 + d] = run;
        __syncthreads();
        float off = 0.f, tot = 0.f;
#pragma unroll
        for (int q = 0; q < 4; ++q) { const float v = TOT[q * 128 + d]; tot += v; if (q < tq) off += v; }
        h16x8 ks0, ks1;
        h16 qh[16];
#pragma unroll
        for (int tt = 0; tt < 16; ++tt) qh[tt] = GQ[(tb + 16 * tq + tt) * 512 + hc];
#pragma unroll
        for (int tt = 0; tt < 16; ++tt) {
            const int t = 16 * tq + tt; const float bb = LA[t * 128 + d] + off;
            h16* qp = GQ + (tb + t) * 512 + hc;
            const float qi = (float)qh[tt] * 0.08838834764831845f * __expf(bb);
            *qp = (h16)qi; QI[t * 136 + d] = (h16)qi;
            const float k = (float)KS[t * 512 + hc];
            KI[t * 136 + d] = (h16)(k * __expf(-bb));
            const h16 kst = (h16)(k * __expf(tot - bb));
            if (tt < 8) ks0[tt] = kst; else ks1[tt - 8] = kst;
        }
        {
            h16* dst = GK + tb * 512 + (size_t)hc * 64 + 16 * tq;
            *(h16x8*)dst = ks0; *(h16x8*)(dst + 8) = ks1;
        }
        if (tq == 0) DECAY[((size_t)item * 4 + h) * 128 + d] = __expf(tot);
        __syncthreads();
        {
            const int it = w >> 1, n16 = lane & 15, g = lane >> 4;
#pragma unroll
            for (int jj = 0; jj < 2; ++jj) {
                const int jt = 2 * (w & 1) + jj;
                f32x4 acc = {0.f, 0.f, 0.f, 0.f};
                if (jt <= it) {
#pragma unroll
                    for (int ks = 0; ks < 4; ++ks) {
                        const h16x8 a = *(const h16x8*)&KI[(16 * jt + n16) * 136 + 32 * ks + 8 * g];
                        const h16x8 bq = *(const h16x8*)&QI[(16 * it + n16) * 136 + 32 * ks + 8 * g];
                        acc = __builtin_amdgcn_mfma_f32_16x16x32_f16(a, bq, acc, 0, 0, 0);
                    }
                }
                const int i = 16 * it + n16, j0 = 16 * jt + 4 * g;
                h16x4 o;
#pragma unroll
                for (int e = 0; e < 4; ++e) o[e] = (j0 + e <= i) ? (h16)acc[e] : (h16)0.f;
                *(h16x4*)(ATTN + ((size_t)item * 4 + h) * 4096 + i * 64 + j0) = o;
            }
        }
        __syncthreads();
#pragma unroll
        for (int r = 0; r < 16; ++r) wg[r] = wgn[r];
        bias = biasn;
    }
    h16* VT = (h16*)smem;
    u32x4 vcur[4], vnxt[4];
#pragma unroll
    for (int i = 0; i < 4; ++i) vcur[i] = ((const u32x4*)(GV + ((size_t)0 * T_ + tb) * 256))[tid + 512 * i];
    for (int h = 0; h < 4; ++h) {
        h16* src = GV + ((size_t)h * T_ + tb) * 256;
#pragma unroll
        for (int i = 0; i < 4; ++i) { const int idx = tid + 512 * i; *(u32x4*)&VT[(idx >> 5) * 264 + (idx & 31) * 8] = vcur[i]; }
        {
            const int hn = h < 3 ? h + 1 : 3;
#pragma unroll
            for (int i = 0; i < 4; ++i) vnxt[i] = ((const u32x4*)(GV + ((size_t)hn * T_ + tb) * 256))[tid + 512 * i];
        }
        asm volatile("s_waitcnt lgkmcnt(0)" ::: "memory"); __builtin_amdgcn_s_barrier(); asm volatile("" ::: "memory");
        {
            const int dv = tid >> 1, hf = tid & 1;
#pragma unroll
            for (int q = 0; q < 4; ++q) {
                h16x8 o;
#pragma unroll
                for (int j = 0; j < 8; ++j) o[j] = VT[(32 * hf + 8 * q + j) * 264 + dv];
                *(h16x8*)(src + (size_t)dv * 64 + 32 * hf + 8 * q) = o;
            }
        }
        asm volatile("s_waitcnt lgkmcnt(0)" ::: "memory"); __builtin_amdgcn_s_barrier(); asm volatile("" ::: "memory");
#pragma unroll
        for (int i = 0; i < 4; ++i) vcur[i] = vnxt[i];
    }
}

__device__ void phase_gla_prep(const Params& P, unsigned char* smem) {
    if (blockIdx.x == 0 && threadIdx.x < 256) ((unsigned*)(P.ws + OFF_CTR))[threadIdx.x] = 0u;
    {
        const int lane = threadIdx.x & 63, gw = blockIdx.x * 8 + (threadIdx.x >> 6), pc = lane & 15;
        const h16* MISC = (const h16*)(P.ws + OFF_MISC); h16* CK = (h16*)(P.ws + OFF_CKVC); h16* IK = (h16*)(P.ws + OFF_IKC);
        float gk[8];
#pragma unroll
        for (int k = 0; k < 8; ++k) gk[k] = P.g_ckv[8 * pc + k];
        for (int r4 = gw; r4 < T_ / 4; r4 += gridDim.x * 8) {
            const int r = 4 * r4 + (lane >> 4);
            const h16x8 v = *(const h16x8*)(MISC + (size_t)r * 256 + 8 * pc);
            u32x4 ikv; if (pc < 8) ikv = *(const u32x4*)(MISC + (size_t)r * 256 + 128 + 8 * pc);
            float ss = 0.f;
#pragma unroll
            for (int k = 0; k < 8; ++k) ss += (float)v[k] * (float)v[k];
            ss += __shfl_xor(ss, 1); ss += __shfl_xor(ss, 2); ss += __shfl_xor(ss, 4); ss += __shfl_xor(ss, 8);
            const float rs = rsqrtf(ss * (1.0f / 128.0f) + LN_EPS);
            h16x8 ov;
#pragma unroll
            for (int k = 0; k < 8; ++k) ov[k] = (h16)((float)v[k] * rs * gk[k]);
            *(h16x8*)(CK + (size_t)r * 128 + 8 * pc) = ov;
            if (pc < 8) *(u32x4*)(IK + (size_t)r * 64 + 8 * pc) = ikv;
        }
    }
    for (int item = blockIdx.x; item < 512; item += gridDim.x) gla_prep_item(P, smem, item);
}

__device__ void gla_rec(const Params& P, unsigned char* smem, int wg) {
    const int tid = threadIdx.x, lane = tid & 63, w = __builtin_amdgcn_readfirstlane(tid >> 6), n16 = lane & 15, g = lane >> 4;
    const int b = wg >> 2, h = wg & 3;
    const h16* GQ = (const h16*)(P.ws + OFF_GQ); const h16* GK = (const h16*)(P.ws + OFF_GK); const h16* GV = (const h16*)(P.ws + OFF_GV);
    const h16* GR = (const h16*)(P.ws + OFF_GR); h16* OA = (h16*)(P.ws + OFF_X16); const h16* ATTN = (const h16*)(P.ws + OFF_ATTN); const float* DECAY = (const float*)(P.ws + OFF_DECAY);
    constexpr int A_OFF = 0, Q_OFF = 9216, K_OFF = 26624, D_OFF = 45056, BUF = 45568, O_OFF = 2 * BUF;
    f32x4 S[8][2];
#pragma unroll
    for (int mt = 0; mt < 8; ++mt) { S[mt][0] = (f32x4){0.f, 0.f, 0.f, 0.f}; S[mt][1] = (f32x4){0.f, 0.f, 0.f, 0.f}; }
    const int piece = tid & 31;
    float gnv[8];
#pragma unroll
    for (int k = 0; k < 8; ++k) gnv[k] = P.g_gla[h * 256 + piece * 8 + k];
    u32x4 st[5], dcy; h16x8 bV[2][2], bVn[2][2];
    auto issue = [&](int n, h16x8 (&bv)[2][2]) {
        const int item = b * 128 + n; const size_t ch = (size_t)item * 4 + h; const size_t tb = (size_t)b * L_ + 64 * n;
        const h16* at = ATTN + ch * 4096;
        const h16* vt = GV + ((size_t)h * T_ + tb) * 256 + (size_t)(32 * w) * 64;
        const h16* qi = GQ + tb * 512 + h * 128;
        const h16* kt = GK + tb * 512 + (size_t)h * 128 * 64;
        const float* dc = DECAY + ch * 128;
        st[0] = *(const u32x4*)(at + (tid >> 3) * 64 + (tid & 7) * 8);
#pragma unroll
        for (int i = 1; i < 3; ++i) { const int cc = tid + 512 * (i - 1); st[i] = *(const u32x4*)(qi + (size_t)(cc >> 4) * 512 + (cc & 15) * 8); }
#pragma unroll
        for (int i = 3; i < 5; ++i) { const int cc = tid + 512 * (i - 3); st[i] = *(const u32x4*)(kt + (size_t)(cc >> 3) * 64 + (cc & 7) * 8); }
        if (tid < 32) dcy = *(const u32x4*)(dc + tid * 4);
#pragma unroll
        for (int ct = 0; ct < 2; ++ct)
#pragma unroll
            for (int ks = 0; ks < 2; ++ks) bv[ct][ks] = *(const h16x8*)(vt + (16 * ct + n16) * 64 + 32 * ks + 8 * g);
    };
    auto commit = [&](int buf) {
        unsigned char* Bn = smem + buf * BUF;
        *(u32x4*)(Bn + A_OFF + (tid >> 3) * 144 + (tid & 7) * 16) = st[0];
#pragma unroll
        for (int i = 1; i < 3; ++i) { const int cc = tid + 512 * (i - 1); *(u32x4*)(Bn + Q_OFF + (cc >> 4) * 272 + (cc & 15) * 16) = st[i]; }
#pragma unroll
        for (int i = 3; i < 5; ++i) { const int cc = tid + 512 * (i - 3); *(u32x4*)(Bn + K_OFF + (cc >> 3) * 144 + (cc & 7) * 16) = st[i]; }
        if (tid < 32) *(u32x4*)(Bn + D_OFF + tid * 16) = dcy;
    };
    issue(0, bV); commit(0);
    __syncthreads();
    for (int n = 0; n < 128; ++n) {
        const size_t tb = (size_t)b * L_ + 64 * n;
        issue(n < 127 ? n + 1 : n, bVn);
        u32x4 grr[4];
#pragma unroll
        for (int j = 0; j < 4; ++j) grr[j] = *(const u32x4*)(GR + (tb + (tid >> 5) + 16 * j) * 1024 + h * 256 + piece * 8);
        const unsigned char* B = smem + (n & 1) * BUF;
        h16x8 sB[2][4];
#pragma unroll
        for (int ct = 0; ct < 2; ++ct)
#pragma unroll
            for (int ks = 0; ks < 4; ++ks) sB[ct][ks] = pack8(S[2 * ks][ct], S[2 * ks + 1][ct]);
#pragma unroll
        for (int tt = 0; tt < 4; ++tt) {
            const int i = 16 * tt + n16;
            h16x8 aA[2], aQ[4];
#pragma unroll
            for (int ks = 0; ks < 2; ++ks) aA[ks] = *(const h16x8*)(B + A_OFF + i * 144 + (32 * ks + 8 * g) * 2);
#pragma unroll
            for (int ks = 0; ks < 4; ++ks) {
                const h16x4 lo = *(const h16x4*)(B + Q_OFF + i * 272 + (32 * ks + 4 * g) * 2), hi = *(const h16x4*)(B + Q_OFF + i * 272 + (32 * ks + 16 + 4 * g) * 2);
                aQ[ks] = (h16x8){lo[0], lo[1], lo[2], lo[3], hi[0], hi[1], hi[2], hi[3]};
            }
#pragma unroll
            for (int ct = 0; ct < 2; ++ct) {
                f32x4 acc = {0.f, 0.f, 0.f, 0.f};
#pragma unroll
                for (int ks = 0; ks < 2; ++ks) acc = __builtin_amdgcn_mfma_f32_16x16x32_f16(aA[ks], bV[ct][ks], acc, 0, 0, 0);
#pragma unroll
                for (int ks = 0; ks < 4; ++ks) acc = __builtin_amdgcn_mfma_f32_16x16x32_f16(aQ[ks], sB[ct][ks], acc, 0, 0, 0);
#pragma unroll
                for (int e = 0; e < 4; ++e) *(h16*)(smem + O_OFF + (16 * tt + 4 * g + e) * 528 + (32 * w + 16 * ct + n16) * 2) = (h16)acc[e];
            }
        }
#pragma unroll
        for (int mt = 0; mt < 8; ++mt) {
            const f32x4 dcv = *(const f32x4*)(B + D_OFF + (16 * mt + 4 * g) * 4);
            h16x8 aK[2];
#pragma unroll
            for (int ks = 0; ks < 2; ++ks) aK[ks] = *(const h16x8*)(B + K_OFF + (16 * mt + n16) * 144 + (32 * ks + 8 * g) * 2);
#pragma unroll
            for (int ct = 0; ct < 2; ++ct) {
                f32x4 acc = S[mt][ct] * dcv;
#pragma unroll
                for (int ks = 0; ks < 2; ++ks) acc = __builtin_amdgcn_mfma_f32_16x16x32_f16(aK[ks], bV[ct][ks], acc, 0, 0, 0);
                S[mt][ct] = acc;
            }
        }
        commit((n + 1) & 1);
        __syncthreads();
#pragma unroll
        for (int j = 0; j < 4; ++j) {
            const int tok = (tid >> 5) + 16 * j;
            const h16x8 ov = *(const h16x8*)(smem + O_OFF + tok * 528 + piece * 16);
            float ss = 0.f;
#pragma unroll
            for (int k = 0; k < 8; ++k) ss += (float)ov[k] * (float)ov[k];
            ss += __shfl_xor(ss, 1); ss += __shfl_xor(ss, 2); ss += __shfl_xor(ss, 4); ss += __shfl_xor(ss, 8); ss += __shfl_xor(ss, 16);
            const float rs = rsqrtf(ss * (1.0f / 256.0f) + LN_EPS);
            const h16x8 gr8 = __builtin_bit_cast(h16x8, grr[j]);
            h16x8 r;
#pragma unroll
            for (int k = 0; k < 8; ++k) r[k] = (h16)((float)ov[k] * rs * gnv[k] * siluf_((float)gr8[k]));
            *(h16x8*)(OA + (tb + tok) * 1024 + h * 256 + piece * 8) = r;
        }
        __syncthreads();
#pragma unroll
        for (int ct = 0; ct < 2; ++ct)
#pragma unroll
            for (int ks = 0; ks < 2; ++ks) bV[ct][ks] = bVn[ct][ks];
    }
}

__device__ __forceinline__ int score_bin(float sc) {
    const h16 hs = (h16)sc;
    const unsigned bits = (unsigned)__builtin_bit_cast(unsigned short, hs);
    const unsigned s16 = bits ^ ((bits & 0x8000u) ? 0xFFFFu : 0x8000u);
    return (int)(s16 >> 6);
}

constexpr int CAPC = 640;
constexpr int DS_HIST = 0, DS_CANDI = 32768, DS_SEL = 69632, DS_CANDS = 77824, DS_KST = 118784, DS_META = 155648, DS_SLOT = 156672, DS_WL = 157696, DS_OST = 77824;

__device__ __forceinline__ h16 bin_edge(int b) {
    if (b < 0) return __builtin_bit_cast(h16, (unsigned short)0xFC00u);
    const unsigned s16 = (unsigned)b << 6;
    const unsigned bits = (s16 & 0x8000u) ? (s16 ^ 0x8000u) : (~s16 & 0xFFFFu);
    return __builtin_bit_cast(h16, (unsigned short)bits);
}

template <int PASS>
__device__ __forceinline__ void dsa_pass(const h16* IKC, unsigned char* smem, int tid, int b, int t0, int nkt, int step, int a0, int ktl, int lane, const h16x8 (&af)[2][4]) {
    unsigned* HIST = (unsigned*)(smem + DS_HIST); float* CANDS = (float*)(smem + DS_CANDS); unsigned short* CANDI = (unsigned short*)(smem + DS_CANDI); int* META = (int*)(smem + DS_META);
    const int half = lane >> 5, r = lane & 31;
    h16 lo[2][2] = {{(h16)0.f, (h16)0.f}, {(h16)0.f, (h16)0.f}};
    if (PASS == 2) {
#pragma unroll
        for (int u = 0; u < 2; ++u) { lo[u][0] = bin_edge(META[4 * (a0 + u) + 2 * half]); lo[u][1] = bin_edge(META[4 * (a0 + u) + 2 * half + 1]); }
    }
    unsigned char* KST = smem + DS_KST;
    const int nst = (nkt + 3) >> 2;
    const int J = (nst + step - 1) / step;
    auto epilogue = [&](int kt, const f32x16& acc, const int u) {
        const int s = 32 * kt + r;
        const int qa0 = 4 * (a0 + u) + 2 * half, qa1 = qa0 + 1; const h16 lo0 = lo[u][0], lo1 = lo[u][1];
        float p[4];
#pragma unroll
        for (int m = 0; m < 4; ++m) { float v = 0.f;
            const f32x4 w4 = *(const f32x4*)(smem + DS_WL + ((4 * (a0 + u) + m) * 2 + half) * 16);
#pragma unroll
            for (int j = 0; j < 4; ++j) { const int ri = __float_as_int(acc[4 * j + m]); v = __builtin_fmaf(w4[j], __int_as_float(ri > 0 ? ri : 0), v); }
            p[m] = v; }
        const auto r02 = __builtin_amdgcn_permlane32_swap(__float_as_uint(p[0]), __float_as_uint(p[2]), false, false);
        const auto r13 = __builtin_amdgcn_permlane32_swap(__float_as_uint(p[1]), __float_as_uint(p[3]), false, false);
        const float sc0 = (__uint_as_float(r02[0]) + __uint_as_float(r02[1])) + 0.0f;
        const float sc1 = (__uint_as_float(r13[0]) + __uint_as_float(r13[1])) + 0.0f;
        const bool v0 = s <= t0 + qa0, v1 = s <= t0 + qa1;
        if (PASS == 1) {
            const int b0 = score_bin(sc0), b1 = score_bin(sc1);
            if (v0) atomicAdd(&HIST[qa0 * 512 + (b0 >> 1)], 1u << (16 * (b0 & 1)));
            if (v1) atomicAdd(&HIST[qa1 * 512 + (b1 >> 1)], 1u << (16 * (b1 & 1)));
        } else {
            if (v0 && (h16)sc0 >= lo0) { const int pos = atomicAdd(&META[48 + qa0], 1); if (pos < CAPC) { CANDS[qa0 * CAPC + pos] = sc0; CANDI[qa0 * CAPC + pos] = (unsigned short)s; } }
            if (v1 && (h16)sc1 >= lo1) { const int pos = atomicAdd(&META[48 + qa1], 1); if (pos < CAPC) { CANDS[qa1 * CAPC + pos] = sc1; CANDI[qa1 * CAPC + pos] = (unsigned short)s; } }
        }
    };
    auto gload = [&](int j, u32x4 (&rg)[2]) {
        if (j > J - 1) j = J - 1;
        const int st = j * step;
#pragma unroll
        for (int i = 0; i < 2; ++i) { const int id = tid + 512 * i; rg[i] = *(const u32x4*)(IKC + ((size_t)b * L_ + 128 * st + (id >> 3)) * 64 + (id & 7) * 8); }
    };
    auto lstore = [&](int buf, const u32x4 (&rg)[2]) {
#pragma unroll
        for (int i = 0; i < 2; ++i) { const int id = tid + 512 * i; *(u32x4*)(KST + buf * 18432 + (id >> 3) * 144 + (id & 7) * 16) = rg[i]; }
    };
    auto stage = [&](int j, int buf) {
        const int st = j * step;
        f32x16 acc[2];
#pragma unroll
        for (int u = 0; u < 2; ++u)
#pragma unroll
            for (int i = 0; i < 16; ++i) acc[u][i] = 0.f;
        h16x8 bfr[4];
#pragma unroll
        for (int ks = 0; ks < 4; ++ks) bfr[ks] = *(const h16x8*)(KST + buf * 18432 + (32 * ktl + r) * 144 + (32 * ks + 16 * half));
        __builtin_amdgcn_s_setprio(1);
#pragma unroll
        for (int ks = 0; ks < 4; ++ks) {
#pragma unroll
            for (int u = 0; u < 2; ++u) acc[u] = __builtin_amdgcn_mfma_f32_32x32x16_f16(af[u][ks], bfr[ks], acc[u], 0, 0, 0);
        }
        __builtin_amdgcn_s_setprio(0);
#pragma unroll
        for (int u = 0; u < 2; ++u) epilogue(4 * st + ktl, acc[u], u);
    };
    u32x4 rg[3][2];
#define LDS_BARRIER() do { asm volatile("s_waitcnt lgkmcnt(0)" ::: "memory"); __builtin_amdgcn_s_barrier(); asm volatile("" ::: "memory"); } while (0)
    gload(0, rg[0]); lstore(0, rg[0]);
#pragma unroll
    for (int i = 0; i < 3; ++i) gload(i + 1, rg[i]);
    LDS_BARRIER();
    for (int k = 0; k < J; k += 6) {
        stage(k, 0); lstore(1, rg[0]); gload(k + 4, rg[0]);
        LDS_BARRIER();
        if (k + 1 >= J) break;
        stage(k + 1, 1); lstore(0, rg[1]); gload(k + 5, rg[1]);
        LDS_BARRIER();
        if (k + 2 >= J) break;
        stage(k + 2, 0); lstore(1, rg[2]); gload(k + 6, rg[2]);
        LDS_BARRIER();
        if (k + 3 >= J) break;
        stage(k + 3, 1); lstore(0, rg[0]); gload(k + 7, rg[0]);
        LDS_BARRIER();
        if (k + 4 >= J) break;
        stage(k + 4, 0); lstore(1, rg[1]); gload(k + 8, rg[1]);
        LDS_BARRIER();
        if (k + 5 >= J) break;
        stage(k + 5, 1); lstore(0, rg[2]); gload(k + 9, rg[2]);
        LDS_BARRIER();
    }
#undef LDS_BARRIER
}

__device__ __forceinline__ void hist_threshold(const unsigned* row, int lane, int R, int& thr, int& above, int& total) {
    unsigned wd[8]; int c = 0;
#pragma unroll
    for (int i = 0; i < 8; ++i) { wd[i] = row[504 - 8 * lane + i]; c += (int)(wd[i] & 0xFFFFu) + (int)(wd[i] >> 16); }
    int pre = c;
#pragma unroll
    for (int off = 1; off < 64; off <<= 1) { const int t = __shfl_up(pre, off); if (lane >= off) pre += t; }
    const int excl = pre - c;
    total = __shfl(pre, 63);
    int mythr = -1, myabove = 0;
    const bool hit = (pre >= R && excl < R);
    if (hit) {
        int cum = excl; bool done = false;
#pragma unroll
        for (int i = 7; i >= 0; --i) {
            const int chi = (int)(wd[i] >> 16), clo = (int)(wd[i] & 0xFFFFu);
            const int binhi = 2 * (504 - 8 * lane + i) + 1;
            if (!done) { if (cum + chi >= R) { mythr = binhi; myabove = cum; done = true; } else cum += chi; }
            if (!done) { if (cum + clo >= R) { mythr = binhi - 1; myabove = cum; done = true; } else cum += clo; }
        }
    }
    const unsigned long long m = __ballot(hit);
    if (m) { const int src = __ffsll((long long)m) - 1; thr = __shfl(mythr, src); above = __shfl(myabove, src); }
    else { thr = -1; above = 0; }
}

__device__ void dsa_tile(const Params& P, unsigned char* smem, int item) {
    const int tid = threadIdx.x, lane = tid & 63, w = __builtin_amdgcn_readfirstlane(tid >> 6);
    const int b = item & 3, qt = 511 - (item >> 2), t0 = qt * 16;
    const int nkt = (t0 + 16 + 31) >> 5;
    const h16* MISC = (const h16*)(P.ws + OFF_MISC); const h16* IQ = (const h16*)(P.ws + OFF_IQ); h16* DQ = (h16*)(P.ws + OFF_DQ);
    const h16* CKVC = (const h16*)(P.ws + OFF_CKVC); const h16* IKC = (const h16*)(P.ws + OFF_IKC);
    unsigned* HIST = (unsigned*)(smem + DS_HIST); float* CANDS = (float*)(smem + DS_CANDS); unsigned short* CANDI = (unsigned short*)(smem + DS_CANDI);
    unsigned short* SEL = (unsigned short*)(smem + DS_SEL); int* META = (int*)(smem + DS_META);
    const int a0 = 2 * (w & 1), ktl = w >> 1;
    h16x8 af[2][4];
    {
        const int half = lane >> 5, r = lane & 31, qloc = r & 3, hh = r >> 2;
#pragma unroll
        for (int u = 0; u < 2; ++u) {
            const size_t tokA = (size_t)b * L_ + t0 + 4 * (a0 + u) + qloc;
#pragma unroll
            for (int ks = 0; ks < 4; ++ks) af[u][ks] = *(const h16x8*)(IQ + tokA * 512 + hh * 64 + 16 * ks + 8 * half);
        }
        if (tid < 128) { const int q = tid >> 3, hf = (tid >> 2) & 1, j = tid & 3;
            ((float*)(smem + DS_WL))[tid] = (float)MISC[((size_t)b * L_ + t0 + q) * 256 + 208 + 2 * j + hf] * 2.82842712474619f; }
    }
    const bool need_hist = (t0 + 16 > CAPC);
    for (int attempt = 0; attempt < 2; ++attempt) {
        const int step = attempt ? 1 : 4;
#pragma unroll
        for (int i = 0; i < 16; ++i) HIST[tid + 512 * i] = 0u;
        if (tid < 128) META[tid] = 0;
        __syncthreads();
        if (need_hist) {
            dsa_pass<1>(IKC, smem, tid, b, t0, nkt, step, a0, ktl, lane, af);
            __syncthreads();
        }
        for (int qq = 0; qq < 2; ++qq) {
            const int q = 2 * w + qq; const int nvalid = t0 + q + 1;
            int lo = -1;
            if (need_hist && nvalid > CAPC) {
                int thr, above, total;
                hist_threshold(HIST + q * 512, lane, 1, thr, above, total);
                int R = attempt ? 256 : (416 * total + nvalid - 1) / nvalid;
                if (R < 1) R = 1;
                hist_threshold(HIST + q * 512, lane, R, thr, above, total);
                lo = thr;
            }
            if (lane == 0) META[q] = lo;
        }
        __syncthreads();
        dsa_pass<2>(IKC, smem, tid, b, t0, nkt, 1, a0, ktl, lane, af);
        __syncthreads();
        if (tid < 16) {
            const int nvalid = t0 + tid + 1, K = nvalid < 256 ? nvalid : 256, cnt = META[48 + tid];
            if (cnt < K || (cnt > CAPC && attempt == 0)) atomicOr(&META[64], 1);
        }
        __syncthreads();
        const int fail = META[64];
        if (fail == 0 || attempt == 1) break;
        __syncthreads();
    }
    for (int qq = 0; qq < 2; ++qq) {
        const int q = 2 * w + qq; const int nvalid = t0 + q + 1, K = nvalid < 256 ? nvalid : 256;
        int C = META[48 + q]; if (C > CAPC) C = CAPC;
        unsigned* row = HIST + q * 512;
#pragma unroll
        for (int i = 0; i < 8; ++i) row[lane + 64 * i] = 0u;
        for (int i = lane; i < C; i += 64) { const int bin = score_bin(CANDS[q * CAPC + i]); atomicAdd(&row[bin >> 1], 1u << (16 * (bin & 1))); }
        int thr, above, total;
        hist_threshold(row, lane, K, thr, above, total);
        float* SMS = (float*)row; unsigned short* SMI = (unsigned short*)(row + 256);
        for (int i = lane; i < C; i += 64) {
            const float sc = CANDS[q * CAPC + i]; const unsigned short idx = CANDI[q * CAPC + i]; const int bin = score_bin(sc);
            if (bin > thr) { const int pos = atomicAdd(&META[32 + q], 1); if (pos < 256) SEL[q * 256 + pos] = idx; }
            else if (bin == thr) { const int pos = atomicAdd(&META[80 + q], 1); if (pos < 256) { SMS[pos] = sc; SMI[pos] = idx; } }
        }
        int Cb = META[80 + q]; if (Cb > 256) Cb = 256;
        const int need = K - above;
        for (int i = lane; i < Cb; i += 64) {
            const float si = SMS[i]; const int ii = SMI[i];
            int rank = 0;
            for (int j = 0; j < Cb; ++j) { const float sj = SMS[j]; const int ij = SMI[j]; rank += (sj > si || (sj == si && ij < ii)) ? 1 : 0; }
            if (rank < need) { const int pos = atomicAdd(&META[32 + q], 1); if (pos < 256) SEL[q * 256 + pos] = (unsigned short)ii; }
        }
        int cnt = META[32 + q]; if (cnt > 256) cnt = 256;
        for (int i = lane; i < 256; i += 64) if (i >= cnt) SEL[q * 256 + i] = 0xFFFFu;
    }
    __syncthreads();
    unsigned char* stage = smem + w * 8704;
    const int n16 = lane & 15, g = lane >> 4;
    for (int qq = 0; qq < 2; ++qq) {
        const int q = 2 * w + qq; const size_t tok = (size_t)b * L_ + t0 + q;
        int cnt = META[32 + q]; if (cnt > 256) cnt = 256;
        h16x8 qf[4];
#pragma unroll
        for (int ks = 0; ks < 4; ++ks) qf[ks] = *(const h16x8*)(DQ + tok * 2048 + n16 * 128 + 32 * ks + 8 * g);
        float m_run = -1e30f, l_run = 0.f;
        f32x4 oacc[8];
#pragma unroll
        for (int c8 = 0; c8 < 8; ++c8) oacc[c8] = (f32x4){0.f, 0.f, 0.f, 0.f};
        u32x4 gvA[8], gvB[8];
        auto gather = [&](int c, u32x4 (&gv)[8]) {
#pragma unroll
            for (int i = 0; i < 8; ++i) {
                const int row = 4 * i + g; const unsigned idx = SEL[q * 256 + 32 * c + row]; const unsigned key = (idx == 0xFFFFu) ? 0u : idx;
                gv[i] = *(const u32x4*)(CKVC + ((size_t)b * L_ + key) * 128 + n16 * 8);
            }
        };
        auto chunk = [&](int c, u32x4 (&gv)[8]) {
            asm volatile("" ::: "memory");
#pragma unroll
            for (int i = 0; i < 8; ++i) *(u32x4*)(stage + (4 * i + g) * 272 + n16 * 16) = gv[i];
            asm volatile("s_waitcnt lgkmcnt(0)" ::: "memory");
            gather(c + 2 < 8 ? c + 2 : 7, gv);
            f32x4 sacc[2];
#pragma unroll
            for (int k2 = 0; k2 < 2; ++k2) {
                f32x4 acc = {0.f, 0.f, 0.f, 0.f};
#pragma unroll
                for (int ks = 0; ks < 4; ++ks) { const h16x8 av = *(const h16x8*)(stage + (16 * k2 + n16) * 272 + (32 * ks + 8 * g) * 2); acc = __builtin_amdgcn_mfma_f32_16x16x32_f16(av, qf[ks], acc, 0, 0, 0); }
                sacc[k2] = acc;
            }
            float lg[2][4]; float cmax = -1e30f;
#pragma unroll
            for (int k2 = 0; k2 < 2; ++k2)
#pragma unroll
                for (int e = 0; e < 4; ++e) { float l = sacc[k2][e] * 0.08838834764831845f;
                    if (cnt < 256) { const int kpos = 32 * c + 16 * k2 + 4 * g + e; l = (kpos < cnt) ? l : -1e30f; }
                    lg[k2][e] = l; }
            cmax = __builtin_fmaxf(__builtin_fmaxf(__builtin_fmaxf(lg[0][0], lg[0][1]), lg[0][2]), __builtin_fmaxf(__builtin_fmaxf(lg[0][3], lg[1][0]), lg[1][1]));
            cmax = __builtin_fmaxf(__builtin_fmaxf(cmax, lg[1][2]), lg[1][3]);
            cmax = fmaxf(cmax, __shfl_xor(cmax, 16)); cmax = fmaxf(cmax, __shfl_xor(cmax, 32));
            if (!__all(cmax - m_run <= 8.0f)) {
                const float m_new = fmaxf(m_run, cmax); const float corr = __expf(m_run - m_new);
#pragma unroll
                for (int c8 = 0; c8 < 8; ++c8) oacc[c8] = oacc[c8] * corr;
                l_run *= corr; m_run = m_new;
            }
            float psum = 0.f; f32x4 p0, p1;
#pragma unroll
            for (int e = 0; e < 4; ++e) { p0[e] = __expf(lg[0][e] - m_run); p1[e] = __expf(lg[1][e] - m_run); psum += p0[e] + p1[e]; }
            l_run += psum;
            const h16x8 pb = pack8(p0, p1);
            __builtin_amdgcn_s_setprio(1);
#pragma unroll
            for (int c8 = 0; c8 < 8; ++c8) {
                const LAS unsigned char* ad = (const LAS unsigned char*)(stage + (4 * g + (n16 >> 2)) * 272 + c8 * 32 + 8 * (n16 & 3));
                const v4s lo = __builtin_amdgcn_ds_read_tr16_b64_v4i16((LAS v4s*)ad);
                const v4s hi = __builtin_amdgcn_ds_read_tr16_b64_v4i16((LAS v4s*)(ad + 16 * 272));
                const h16x4 l4 = __builtin_bit_cast(h16x4, lo), h4 = __builtin_bit_cast(h16x4, hi);
                const h16x8 av = (h16x8){l4[0], l4[1], l4[2], l4[3], h4[0], h4[1], h4[2], h4[3]};
                oacc[c8] = __builtin_amdgcn_mfma_f32_16x16x32_f16(av, pb, oacc[c8], 0, 0, 0);
            }
            __builtin_amdgcn_s_setprio(0);
            asm volatile("s_waitcnt lgkmcnt(0)" ::: "memory");
        };
        gather(0, gvA); gather(1, gvB);
        for (int c = 0; c < 8; c += 2) { chunk(c, gvA); chunk(c + 1, gvB); }
        float lt = l_run; lt += __shfl_xor(lt, 16); lt += __shfl_xor(lt, 32);
        const float inv = 1.0f / lt;
#pragma unroll
        for (int c8 = 0; c8 < 8; ++c8) {
            h16x4 ov;
#pragma unroll
            for (int e = 0; e < 4; ++e) ov[e] = (h16)(oacc[c8][e] * inv);
            *(h16x4*)(smem + DS_OST + (n16 * 16 + q) * 272 + (16 * c8 + 4 * g) * 2) = ov;
        }
    }
    __syncthreads();
    {
        const h16* WUVT = (const h16*)(P.ws + OFF_WCOMB + 2 * MiB);
#pragma unroll
        for (int hh = 0; hh < 2; ++hh) {
            const int h = 2 * w + hh;
            h16x8 bq[4];
#pragma unroll
            for (int ks = 0; ks < 4; ++ks) bq[ks] = *(const h16x8*)(smem + DS_OST + (h * 16 + n16) * 272 + (32 * ks + 8 * g) * 2);
#pragma unroll
            for (int nt = 0; nt < 4; ++nt) {
                f32x4 acc = {0.f, 0.f, 0.f, 0.f};
#pragma unroll
                for (int ks = 0; ks < 4; ++ks) { const h16x8 av = *(const h16x8*)(WUVT + (size_t)(h * 64 + 16 * nt + n16) * 128 + 32 * ks + 8 * g); acc = __builtin_amdgcn_mfma_f32_16x16x32_f16(av, bq[ks], acc, 0, 0, 0); }
                h16x4 ov; ov[0] = (h16)acc[0]; ov[1] = (h16)acc[1]; ov[2] = (h16)acc[2]; ov[3] = (h16)acc[3];
                *(h16x4*)(DQ + ((size_t)b * L_ + t0 + n16) * 2048 + h * 64 + 16 * nt + 4 * g) = ov;
            }
        }
    }
    __syncthreads();
}

__device__ void phase_mixers(const Params& P, unsigned char* smem) {
    if (blockIdx.x < 16) for (int rep = 0; rep <= P.pad1; ++rep) gla_rec(P, smem, blockIdx.x);
    __syncthreads();
    unsigned* ctr = (unsigned*)(P.ws + OFF_CTR);
    int* slot = (int*)(smem + DS_SLOT);
    const int b0 = ((int)blockIdx.x & 7) >> 1;
    for (int bi = 0; bi < 4; ++bi) {
        const int b = (b0 + bi) & 3;
        for (;;) {
            if (threadIdx.x == 0) *slot = (int)atomicAdd(ctr + 64 * b, 1u);
            __syncthreads();
            const int it = *slot;
            __syncthreads();
            if (it >= 512) break;
            dsa_tile(P, smem, it * 4 + b);
        }
    }
}

__device__ void ln_rows(const float* v, const float* g, const float* bb, h16* o16, float* o32) {
    const int lane = threadIdx.x & 63, gw = blockIdx.x * 8 + (threadIdx.x >> 6);
    f32x4 gg[4], bv[4];
#pragma unroll
    for (int i = 0; i < 4; ++i) { gg[i] = ((const f32x4*)g)[lane + 64 * i]; bv[i] = ((const f32x4*)bb)[lane + 64 * i]; }
    for (int r = gw; r < T_; r += gridDim.x * 8) {
        const f32x4* rp = (const f32x4*)(v + (size_t)r * 1024);
        f32x4 a[4]; float s = 0.f;
#pragma unroll
        for (int i = 0; i < 4; ++i) { a[i] = rp[lane + 64 * i]; s += (a[i][0] + a[i][1]) + (a[i][2] + a[i][3]); }
#pragma unroll
        for (int o = 32; o >= 1; o >>= 1) s += __shfl_xor(s, o);
        const float mean = s * (1.0f / 1024.0f);
        float q = 0.f;
#pragma unroll
        for (int i = 0; i < 4; ++i) { a[i] = a[i] - mean; q += (a[i][0] * a[i][0] + a[i][1] * a[i][1]) + (a[i][2] * a[i][2] + a[i][3] * a[i][3]); }
#pragma unroll
        for (int o = 32; o >= 1; o >>= 1) q += __shfl_xor(q, o);
        const float rstd = rsqrtf(q * (1.0f / 1024.0f) + LN_EPS);
#pragma unroll
        for (int i = 0; i < 4; ++i) {
            const f32x4 y = a[i] * rstd * gg[i] + bv[i];
            if (o16) { h16x4 hv; hv[0] = (h16)y[0]; hv[1] = (h16)y[1]; hv[2] = (h16)y[2]; hv[3] = (h16)y[3]; ((h16x4*)(o16 + (size_t)r * 1024))[lane + 64 * i] = hv; }
            else ((f32x4*)(o32 + (size_t)r * 1024))[lane + 64 * i] = y;
        }
    }
}

__device__ void ln_rows16(h16* v, const float* g, const float* bb) {
    const int lane = threadIdx.x & 63, gw = blockIdx.x * 8 + (threadIdx.x >> 6);
    f32x4 gg[4], bv[4];
#pragma unroll
    for (int i = 0; i < 4; ++i) { gg[i] = ((const f32x4*)g)[4 * lane + i]; bv[i] = ((const f32x4*)bb)[4 * lane + i]; }
    for (int r = gw; r < T_; r += gridDim.x * 8) {
        h16x8* rp = (h16x8*)(v + (size_t)r * 1024 + 16 * lane);
        const h16x8 h0 = rp[0], h1 = rp[1];
        float a[16]; float s = 0.f;
#pragma unroll
        for (int k = 0; k < 8; ++k) { a[k] = (float)h0[k]; a[8 + k] = (float)h1[k]; }
#pragma unroll
        for (int k = 0; k < 16; ++k) s += a[k];
#pragma unroll
        for (int o = 32; o >= 1; o >>= 1) s += __shfl_xor(s, o);
        const float mean = s * (1.0f / 1024.0f);
        float q = 0.f;
#pragma unroll
        for (int k = 0; k < 16; ++k) { a[k] -= mean; q += a[k] * a[k]; }
#pragma unroll
        for (int o = 32; o >= 1; o >>= 1) q += __shfl_xor(q, o);
        const float rstd = rsqrtf(q * (1.0f / 1024.0f) + LN_EPS);
        h16x8 o0, o1;
#pragma unroll
        for (int k = 0; k < 8; ++k) { o0[k] = (h16)(a[k] * rstd * gg[k >> 2][k & 3] + bv[k >> 2][k & 3]); o1[k] = (h16)(a[8 + k] * rstd * gg[2 + (k >> 2)][k & 3] + bv[2 + (k >> 2)][k & 3]); }
        rp[0] = o0; rp[1] = o1;
    }
}

__device__ void phase_halo(const Params& P) {
    const h16* H = (const h16*)(P.ws + OFF_H); h16* HALO = (h16*)(P.ws + OFF_HALO);
    for (int blk = blockIdx.x; blk < 256; blk += gridDim.x) {
        const int r0 = blk * 128; const bool first = (r0 % L_) == 0;
        for (int i = threadIdx.x; i < 2 * 5632 / 2; i += blockDim.x) {
            const int rr = i / 2816, cc = (i % 2816) * 2;
            h16x2 v; v[0] = (h16)0.f; v[1] = (h16)0.f;
            if (!first) v = *(const h16x2*)(H + (size_t)(r0 - 2 + rr) * 5632 + cc);
            *(h16x2*)(HALO + ((size_t)blk * 2 + rr) * 5632 + cc) = v;
        }
    }
}

__device__ void phase_convact(const Params& P) {
    h16* H = (h16*)(P.ws + OFF_H); const h16* HALO = (const h16*)(P.ws + OFF_HALO);
    for (int blk = blockIdx.x; blk < 256; blk += gridDim.x) {
        const int r0 = blk * 128;
        const int cg8 = threadIdx.x;
        if (cg8 < 352) {
            const int c = 8 * cg8;
            float wg[3][8], wvv[3][8], bg[8], bvv[8];
#pragma unroll
            for (int j = 0; j < 3; ++j)
#pragma unroll
                for (int k = 0; k < 8; ++k) { wg[j][k] = P.conv_w[j * 5632 + c + k]; wvv[j][k] = P.conv_w[j * 5632 + 2816 + c + k]; }
#pragma unroll
            for (int k = 0; k < 8; ++k) { bg[k] = P.conv_b[c + k]; bvv[k] = P.conv_b[2816 + c + k]; }
            h16x8 g2, v2, g1, v1;
#pragma unroll
            for (int k = 0; k < 8; ++k) { g2[k] = (h16)0.f; v2[k] = (h16)0.f; g1[k] = (h16)0.f; v1[k] = (h16)0.f; }
            if ((r0 % L_) != 0) {
                g2 = *(const h16x8*)(HALO + ((size_t)blk * 2 + 0) * 5632 + c); v2 = *(const h16x8*)(HALO + ((size_t)blk * 2 + 0) * 5632 + 2816 + c);
                g1 = *(const h16x8*)(HALO + ((size_t)blk * 2 + 1) * 5632 + c); v1 = *(const h16x8*)(HALO + ((size_t)blk * 2 + 1) * 5632 + 2816 + c);
            }
            for (int rr = 0; rr < 128; rr += 4) {
                h16x8 gq[4], vq[4];
#pragma unroll
                for (int u = 0; u < 4; ++u) { const h16* rp = H + (size_t)(r0 + rr + u) * 5632; gq[u] = *(const h16x8*)(rp + c); vq[u] = *(const h16x8*)(rp + 2816 + c); }
#pragma unroll
                for (int u = 0; u < 4; ++u) {
                    h16x8 o;
#pragma unroll
                    for (int k = 0; k < 8; ++k) {
                        const float cgv = wg[2][k] * (float)gq[u][k] + wg[1][k] * (float)g1[k] + wg[0][k] * (float)g2[k] + bg[k];
                        const float cvv = wvv[2][k] * (float)vq[u][k] + wvv[1][k] * (float)v1[k] + wvv[0][k] * (float)v2[k] + bvv[k];
                        o[k] = (h16)(siluf_(cgv) * cvv);
                    }
                    *(h16x8*)(H + (size_t)(r0 + rr + u) * 5632 + c) = o;
                    g2 = g1; g1 = gq[u]; v2 = v1; v1 = vq[u];
                }
            }
        }
    }
}

__device__ __forceinline__ void run_phase(const Params& P, unsigned char* smem, const int ph) {
    unsigned char* ws = P.ws;
    switch (ph) {
#ifdef ONLY_PHASE
    case ONLY_PHASE + 100: break;
#endif
    case 0: phase_prep(P, smem); break;
    case 1: gm::run_gemm<0>(smem, (const h16*)(ws + OFF_X16), 1024, (const h16*)(ws + OFF_WIN), T_, 7936, 1024, (void*)P.out, nullptr, nullptr, 0, ws); break;
    case 2: phase_gla_prep(P, smem); break;
    case 3: phase_mixers(P, smem); break;
    case 4:
        cvt_f32_to_h16(P.p, (h16*)(ws + OFF_P16), (size_t)T_ * 256);
        gm::run_gemm<1>(smem, (const h16*)(ws + OFF_X16), 1024, (const h16*)(ws + OFF_WGLA), T_, 1024, 1024, (void*)(ws + OFF_MERGED), (const void*)P.out, nullptr, 1024, ws);
        gm::run_gemm<2>(smem, (const h16*)(ws + OFF_DQ), 2048, (const h16*)(ws + OFF_WCOMB), T_, 1024, 1024, (void*)(ws + OFF_MERGED), (const void*)P.out, nullptr, 1024, ws);
        break;
    case 5: gm::run_gemm<3>(smem, (const h16*)(ws + OFF_MERGED), 1024, (const h16*)(ws + OFF_WOUT), T_, 1024, 1024, (void*)(ws + OFF_X16), (const void*)P.x, nullptr, 1024, ws); break;
    case 6: ln_rows16((h16*)(ws + OFF_X16), P.ln1_g, P.ln1_b); break;
    case 7: gm::run_gemm<4>(smem, (const h16*)(ws + OFF_X16), 1024, (const h16*)(ws + OFF_WUP), T_, 5632, 1024, (void*)(ws + OFF_H), nullptr, nullptr, 5632, ws); break;
    case 9: phase_convact(P); break;
    case 10: gm::run_gemm<5>(smem, (const h16*)(ws + OFF_H), 5632, (const h16*)(ws + OFF_WDOWN), T_, 1024, 2816, (void*)(ws + OFF_X16), (const void*)(ws + OFF_X16), nullptr, 1024, ws); break;
    case 11: ln_rows16((h16*)(ws + OFF_X16), P.ln2_g, P.ln2_b); break;
    case 12:
        gm::run_gemm<6>(smem, (const h16*)(ws + OFF_X16), 1024, (const h16*)(ws + OFF_WPG), T_, 1024, 1024, (void*)(ws + OFF_G), nullptr, nullptr, 1024, ws);
        gm::run_gemm<7>(smem, (const h16*)(ws + OFF_P16), 256, (const h16*)(ws + OFF_WPLE), T_, 1024, 256, (void*)P.out, (const void*)(ws + OFF_X16), (const void*)(ws + OFF_G), 1024, ws);
        break;
    case 13: ln_rows(P.out, P.ln3_g, P.ln3_b, nullptr, P.out); break;
    default: break;
    }
}

__device__ __forceinline__ void fast_grid_sync(unsigned* ctr, unsigned target) {
    __syncthreads();
    if (threadIdx.x == 0) {
        __builtin_amdgcn_fence(__ATOMIC_RELEASE, "agent");
        __hip_atomic_fetch_add(ctr, 1u, __ATOMIC_RELAXED, __HIP_MEMORY_SCOPE_AGENT);
        while (__hip_atomic_load(ctr, __ATOMIC_RELAXED, __HIP_MEMORY_SCOPE_AGENT) < target) __builtin_amdgcn_s_sleep(1);
        __builtin_amdgcn_fence(__ATOMIC_ACQUIRE, "agent");
    }
    __syncthreads();
}

__global__ void __launch_bounds__(512, 2) fwd_megakernel(Params P) {
    extern __shared__ __attribute__((aligned(16))) unsigned char smem[];
    cg::grid_group grid = cg::this_grid();
    unsigned* gbar = (unsigned*)(P.ws + OFF_CTR + 4096); unsigned nbar = 0;
#define RUNPH(k) do { if (P.phase_lo <= (k) && (k) < P.phase_hi) run_phase(P, smem, (k)); \
        if (P.phase_lo <= (k) && (k) + 1 < P.phase_hi) { if ((k) == 0) grid.sync(); else { ++nbar; fast_grid_sync(gbar, nbar * gridDim.x); } } } while (0)
    RUNPH(0); RUNPH(1); RUNPH(2); RUNPH(3); RUNPH(4); RUNPH(5); RUNPH(6); RUNPH(7); RUNPH(9); RUNPH(10); RUNPH(11); RUNPH(12); RUNPH(13);
#undef RUNPH
}

extern "C" void kernel_launch(void* const* d_in, const int* in_sizes, int n_in, void* d_out, int out_size, void* d_ws, size_t ws_size, hipStream_t stream) {
    static int grid = 0;
    if (grid == 0) {
        if (n_in != 23 || ws_size < WS_NEED) { fprintf(stderr, "kernel_launch: need 23 inputs and >= %zu bytes of workspace; got %d, %zu\n", (size_t)WS_NEED, n_in, ws_size); grid = -1; return; }
        int dev = 0, cus = 0, per_cu = 0;
        hipGetDevice(&dev);
        hipDeviceGetAttribute(&cus, hipDeviceAttributeMultiprocessorCount, dev);
        if (hipFuncSetAttribute((const void*)fwd_megakernel, hipFuncAttributeMaxDynamicSharedMemorySize, SMEM_BYTES) != hipSuccess) { fprintf(stderr, "kernel_launch: hipFuncSetAttribute failed\n"); grid = -1; return; }
        if (hipOccupancyMaxActiveBlocksPerMultiprocessor(&per_cu, (const void*)fwd_megakernel, 512, SMEM_BYTES) != hipSuccess || per_cu < 1) { fprintf(stderr, "kernel_launch: occupancy query gives %d\n", per_cu); grid = -1; return; }
        (void)hipGetLastError();
        grid = cus;
    }
    if (grid < 0) return;
    Params p{};
    const float** pp = (const float**)&p;
    for (int i = 0; i < 23; ++i) pp[i] = (const float*)d_in[i];
    p.out = (float*)d_out; p.ws = (unsigned char*)d_ws; p.pad1 = PROBE_GLA_REP; p.pad0 = PROBE_SEL_REP;
#if MULTI_LAUNCH
    static const int seq[] = PROBE_SEQ;
    for (int i = 0; i < (int)(sizeof(seq) / sizeof(int)); ++i) {
        p.phase_lo = seq[i]; p.phase_hi = seq[i] + 1;
        hipLaunchKernelGGL(fwd_megakernel, dim3(grid), dim3(512), SMEM_BYTES, stream, p);
    }
#else
    hipMemsetAsync((unsigned char*)d_ws + OFF_CTR + 4096, 0, 256, stream);
    p.phase_lo = 0; p.phase_hi = NPHASE;
    void* args[] = {&p};
    hipError_t e = hipLaunchCooperativeKernel((const void*)fwd_megakernel, dim3(grid), dim3(512), args, SMEM_BYTES, stream);
    if (e != hipSuccess) fprintf(stderr, "cooperative launch failed: %s (grid %d)\n", hipGetErrorString(e), grid);
#endif
}
```

```cpp
#include <hip/hip_runtime.h>
#include <hip/hip_cooperative_groups.h>
#include <cstdio>
namespace cg = cooperative_groups;

#ifndef MULTI_LAUNCH
#define MULTI_LAUNCH 0
#endif
#ifndef PROBE_SEL_REP
#define PROBE_SEL_REP 0
#endif
#ifndef PROBE_GLA_REP
#define PROBE_GLA_REP 0
#endif
#ifndef PROBE_SEQ
#define PROBE_SEQ {0,1,2,3,4,5,6,7,9,10,11,12,13}
#endif

#define LAS __attribute__((address_space(3)))
typedef _Float16 h16;
typedef _Float16 h16x2 __attribute__((ext_vector_type(2)));
typedef _Float16 h16x4 __attribute__((ext_vector_type(4)));
typedef _Float16 h16x8 __attribute__((ext_vector_type(8)));
typedef float f32x2 __attribute__((ext_vector_type(2)));
typedef float f32x4 __attribute__((ext_vector_type(4)));
typedef float f32x16 __attribute__((ext_vector_type(16)));
typedef unsigned u32x2 __attribute__((ext_vector_type(2)));
typedef unsigned u32x4 __attribute__((ext_vector_type(4)));
typedef short v4s __attribute__((__vector_size__(8)));

constexpr int T_ = 32768, L_ = 8192;
constexpr float ALPHA = 1.189207115002721f;
constexpr float LN_EPS = 1e-5f;
constexpr size_t MiB = (size_t)1 << 20;
constexpr int NPHASE = 14;
constexpr int SMEM_BYTES = 163840;

constexpr size_t OFF_WIN = 0;
constexpr size_t OFF_WUP = OFF_WIN + (size_t)7936 * 1024 * 2;
constexpr size_t OFF_WDOWN = OFF_WUP + (size_t)5632 * 1024 * 2;
constexpr size_t OFF_WGLA = OFF_WDOWN + (size_t)1024 * 2816 * 2;
constexpr size_t OFF_WCOMB = OFF_WGLA + (size_t)1024 * 1024 * 2;
constexpr size_t OFF_WOUT = OFF_WCOMB + (size_t)1024 * 2048 * 2;
constexpr size_t OFF_WPG = OFF_WOUT + (size_t)1024 * 1024 * 2;
constexpr size_t OFF_WPLE = OFF_WPG + (size_t)1024 * 1024 * 2;
constexpr size_t OFF_X16 = 44 * MiB;
constexpr size_t OFF_PROJ = 108 * MiB;
constexpr size_t OFF_GQ = OFF_PROJ;
constexpr size_t OFF_GK = OFF_PROJ + 32 * MiB;
constexpr size_t OFF_GV = OFF_PROJ + 64 * MiB;
constexpr size_t OFF_GR = OFF_PROJ + 128 * MiB;
constexpr size_t OFF_DQ = OFF_PROJ + 192 * MiB;
constexpr size_t OFF_MISC = OFF_PROJ + 320 * MiB;
constexpr size_t OFF_IQ = OFF_PROJ + 336 * MiB;
constexpr size_t OFF_MERGED = OFF_PROJ;
constexpr size_t OFF_P16 = OFF_PROJ + 352 * MiB;
constexpr size_t OFF_H = OFF_PROJ;
constexpr size_t OFF_G = OFF_PROJ;
constexpr size_t OFF_ATTN = 476 * MiB;
constexpr size_t OFF_DECAY = 492 * MiB;
constexpr size_t OFF_HALO = 493 * MiB;
constexpr size_t OFF_CTR = 43 * MiB;
constexpr size_t OFF_CKVC = 493 * MiB;
constexpr size_t OFF_IKC = 501 * MiB;
constexpr size_t WS_NEED = 505 * MiB;

struct Params {
    const float *x, *p, *w_in, *w_gate_up, *b_gate, *g_gla, *w_gla_proj, *g_ckv, *w_uv, *w_dsa_proj, *w_out, *ln1_g, *ln1_b,
        *w_up, *conv_w, *conv_b, *w_down, *ln2_g, *ln2_b, *w_ple, *w_ple_gate, *ln3_g, *ln3_b;
    float* out;
    unsigned char* ws;
    int phase_lo, phase_hi, pad0, pad1;
};

__device__ __forceinline__ float sigmoidf_(float x) { return __builtin_amdgcn_rcpf(1.0f + __expf(-x)); }
__device__ __forceinline__ float siluf_(float x) { return x * __builtin_amdgcn_rcpf(1.0f + __expf(-x)); }
__device__ __forceinline__ h16x8 pack8(f32x4 a, f32x4 b) {
    h16x8 r; r[0] = (h16)a[0]; r[1] = (h16)a[1]; r[2] = (h16)a[2]; r[3] = (h16)a[3]; r[4] = (h16)b[0]; r[5] = (h16)b[1]; r[6] = (h16)b[2]; r[7] = (h16)b[3]; return r;
}

namespace gm {
constexpr int BM = 256, BK = 64, HALF = 128, HTB = HALF * BK * 2, NXCD = 8, WGM = 8;
__device__ __forceinline__ int lds_byte(int r, int c) { const int st = (r >> 4) * 2 + (c >> 5), rr = r & 15, cc = c & 31, ob = rr * 64 + cc * 2; return st * 1024 + (ob ^ (((ob >> 9) & 1) << 5)); }
__device__ __forceinline__ void stage_rc(int b, int& R, int& C) { const int st = b / 1024, sb = b % 1024, swz = sb ^ (((sb >> 9) & 1) << 5); R = (st >> 1) * 16 + swz / 64; C = (st & 1) * 32 + (swz % 64) / 2; }
__device__ __forceinline__ int perm32(int rho) { const int n = rho >> 4, i = rho & 15; return 8 * (i >> 2) + 4 * n + (i & 3); }
struct Unit { int pm, pn; };
struct Gemm { const h16* A; const h16* Bt; int M, N, K, lda; };
struct StaticOrder {
    int nM, nN, nwg, G, c;
    __device__ void init(int M, int N, int G_, int c_) { nM = M / BM; nN = N / BM; nwg = nM * nN; G = G_; c = c_; }
    __device__ bool next(int i, Unit& u) const {
        const long Lx = (long)i * G + c; if (Lx >= nwg) return false;
        int wgid = (int)Lx; { const int q = nwg / NXCD, r = nwg % NXCD, xcd = wgid % NXCD, off = wgid / NXCD; wgid = (xcd < r ? xcd * (q + 1) : r * (q + 1) + (xcd - r) * q) + off; }
        const int nig = WGM * nN, gid = wgid / nig, fm = gid * WGM, gsz = (nM - fm) < WGM ? (nM - fm) : WGM;
        u.pm = fm + ((wgid % nig) % gsz); u.pn = (wgid % nig) / gsz; return true;
    }
};

template <int MODE> struct Epi {
    static constexpr bool PERM = (MODE == 0 || MODE == 1 || MODE == 2 || MODE == 4 || MODE == 6);
    void* o; const void* a1; const void* a2; int ldc; unsigned char* ws;
    __device__ __forceinline__ void operator()(const f32x4 (&acc)[2][2][4][2], const Unit& u, int wr, int wc, int fr, int fq) const {
        const int row0 = u.pm * BM + wr * 64 + fr;
        if constexpr (PERM) {
            int colt = u.pn * BM; h16* base = (h16*)o; int ld = ldc; bool sig = (MODE == 6);
            if constexpr (MODE == 0) {
                const int pn = u.pn;
                if (pn < 2) { base = (h16*)(ws + OFF_GQ); ld = 512; colt = pn * 256; }
                else if (pn < 4) { base = (h16*)(ws + OFF_GK); ld = 512; colt = (pn - 2) * 256; }
                else if (pn < 8) { base = (h16*)(ws + OFF_GV) + (size_t)(pn - 4) * T_ * 256; ld = 256; colt = 0; }
                else if (pn < 12) { base = (h16*)(ws + OFF_GR); ld = 1024; colt = (pn - 8) * 256; }
                else if (pn < 20) { base = (h16*)(ws + OFF_DQ); ld = 2048; colt = (pn - 12) * 256; }
                else if (pn == 20) { base = (h16*)(ws + OFF_MISC); ld = 256; colt = 0; }
                else if (pn < 23) { base = (h16*)(ws + OFF_IQ); ld = 512; colt = (pn - 21) * 256; }
                else { base = (h16*)o; ld = 2048; colt = (pn - 23) * 256; sig = true; }
            }
            const int col0 = colt + wc * 32 + 8 * fq;
            h16x8 sgv[2][2], pvv[2][2];
            auto ldm = [&](int gi, int slot) {
                if constexpr (MODE == 1 || MODE == 2) {
                    const int row = row0 + (gi >> 2) * HALF + (gi & 3) * 16;
#pragma unroll
                    for (int bj = 0; bj < 2; ++bj) {
                        sgv[slot][bj] = *(const h16x8*)((const h16*)a1 + (size_t)row * 2048 + (MODE == 2 ? 1024 : 0) + col0 + bj * HALF);
                        if constexpr (MODE == 2) pvv[slot][bj] = *(const h16x8*)(base + (size_t)row * ld + col0 + bj * HALF);
                    }
                }
            };
            ldm(0, 0);
#pragma unroll
            for (int gi = 0; gi < 8; ++gi) {
                const int slot = gi & 1, ai = gi >> 2, m = gi & 3;
                if (gi < 7) ldm(gi + 1, slot ^ 1);
                {
                    const int row = row0 + ai * HALF + m * 16;
                    h16* rowp = base + (size_t)row * ld + col0;
#pragma unroll
                    for (int bj = 0; bj < 2; ++bj) {
                        f32x4 v0 = acc[ai][bj][m][0], v1 = acc[ai][bj][m][1];
                        if (sig) {
#pragma unroll
                            for (int j = 0; j < 4; ++j) { v0[j] = sigmoidf_(v0[j]); v1[j] = sigmoidf_(v1[j]); }
                        }
                        if constexpr (MODE == 1 || MODE == 2) {
                            const h16x8 sg = sgv[slot][bj];
#pragma unroll
                            for (int j = 0; j < 4; ++j) { v0[j] *= (float)sg[j]; v1[j] *= (float)sg[4 + j]; }
                            if constexpr (MODE == 2) {
                                const h16x8 pv = pvv[slot][bj];
#pragma unroll
                                for (int j = 0; j < 4; ++j) { v0[j] += (float)pv[j]; v1[j] += (float)pv[4 + j]; }
                            }
                        }
                        *(h16x8*)(rowp + bj * HALF) = pack8(v0, v1);
                        if constexpr (MODE == 4) {
                            if (wr == 1 && m == 3 && fr >= 14 && (row >> 7) + 1 < 256)
                                *(h16x8*)((h16*)(ws + OFF_HALO) + ((size_t)((row >> 7) + 1) * 2 + (fr - 14)) * 5632 + col0 + bj * HALF) = pack8(v0, v1);
                        }
                    }
                    asm volatile("" ::: "memory");
                }
            }
        } else {
            const int col0 = u.pn * BM + wc * 32 + 4 * fq;
            f32x4 bs[2][4]; h16x4 gg[2][4];
            auto ld = [&](int gi, int slot) {
                const int row = row0 + (gi >> 2) * HALF + (gi & 3) * 16; const size_t off = (size_t)row * 1024 + col0;
#pragma unroll
                for (int q = 0; q < 4; ++q) {
                    const size_t o2 = off + (q >> 1) * HALF + (q & 1) * 16;
                    if constexpr (MODE == 3) bs[slot][q] = *(const f32x4*)((const float*)a1 + o2);
                    else { const h16x4 hb = *(const h16x4*)((const h16*)a1 + o2); bs[slot][q] = (f32x4){(float)hb[0], (float)hb[1], (float)hb[2], (float)hb[3]}; }
                    if constexpr (MODE == 7) gg[slot][q] = *(const h16x4*)((const h16*)a2 + o2);
                }
            };
            ld(0, 0);
#pragma unroll
            for (int gi = 0; gi < 8; ++gi) {
                const int slot = gi & 1;
                if (gi < 7) ld(gi + 1, slot ^ 1);
                const int ai = gi >> 2, m = gi & 3;
                const int row = row0 + ai * HALF + m * 16; const size_t off = (size_t)row * 1024 + col0;
#pragma unroll
                for (int q = 0; q < 4; ++q) {
                    const int bj = q >> 1, n = q & 1; const size_t o2 = off + bj * HALF + n * 16;
                    f32x4 v = acc[ai][bj][m][n];
                    if constexpr (MODE == 7) { v[0] *= (float)gg[slot][q][0]; v[1] *= (float)gg[slot][q][1]; v[2] *= (float)gg[slot][q][2]; v[3] *= (float)gg[slot][q][3]; }
                    const f32x4 rv = bs[slot][q] * ALPHA + v;
                    if constexpr (MODE == 7) *(f32x4*)((float*)o + o2) = rv;
                    else { h16x4 hv; hv[0] = (h16)rv[0]; hv[1] = (h16)rv[1]; hv[2] = (h16)rv[2]; hv[3] = (h16)rv[3]; *(h16x4*)((h16*)o + o2) = hv; }
                }
                asm volatile("" ::: "memory");
            }
        }
    }
};

template <class EpiT>
__device__ __forceinline__ void gemm_phase(LAS unsigned char* lds, const Gemm g, const StaticOrder& S, const EpiT& E) {
    const int tid = threadIdx.x, wid = __builtin_amdgcn_readfirstlane(tid >> 6), lane = tid & 63, wr = wid >> 2, wc = wid & 3, fr = lane & 15, fq = lane >> 4;
    const int K = g.K, nt = K / BK, lda = g.lda;
    unsigned voffA[2], voffB[2];
#pragma unroll
    for (int i = 0; i < 2; ++i) { int R, C; stage_rc(tid * 16 + i * 8192, R, C); const int Rb = EpiT::PERM ? ((R & ~31) + perm32(R & 31)) : R;
        voffA[i] = (unsigned)(R * lda + C) * 2u; voffB[i] = (unsigned)(Rb * K + C) * 2u; }
    const size_t kstep = (size_t)(BK * 2);
    const size_t hstepA = (size_t)HALF * lda * 2, hstepB = (size_t)HALF * K * 2;
    const size_t tstepA = 2 * hstepA, tstepB = 2 * hstepB;
    const unsigned ldsw = (unsigned)wid * 1024u;
    const int aoff = lds_byte(wr * 64 + fr, fq * 8), boff = lds_byte(wc * 32 + fr, fq * 8);
#define PG8_SA(b, h) (((b) * 2 + (h)) * HTB)
#define PG8_SB(b, h) ((4 + (b) * 2 + (h)) * HTB)
#define PG8_STAGE(bufoff, gbase, voff) do { _Pragma("unroll") for (int _i = 0; _i < 2; ++_i) \
        __builtin_amdgcn_global_load_lds((const unsigned*)((const char*)(gbase) + (voff)[_i]), (LAS unsigned*)(lds + (bufoff) + ldsw + _i * 8192), 16, 0, 0); } while (0)
#define PG8_LDA(dst, b, h) do { _Pragma("unroll") for (int m = 0; m < 4; ++m) _Pragma("unroll") for (int k = 0; k < 2; ++k) dst[m][k] = *(const LAS h16x8*)(lds + PG8_SA(b, h) + aoff + m * 2048 + k * 1024); } while (0)
#define PG8_LDB(dst, b, h) do { _Pragma("unroll") for (int n = 0; n < 2; ++n) _Pragma("unroll") for (int k = 0; k < 2; ++k) dst[n][k] = *(const LAS h16x8*)(lds + PG8_SB(b, h) + boff + n * 2048 + k * 1024); } while (0)
#define PG8_MMA(ai, bj, At, Bt) do { __builtin_amdgcn_s_setprio(1); _Pragma("unroll") for (int m = 0; m < 4; ++m) _Pragma("unroll") for (int n = 0; n < 2; ++n) _Pragma("unroll") for (int k = 0; k < 2; ++k) \
        acc[ai][bj][m][n] = __builtin_amdgcn_mfma_f32_16x16x32_f16(Bt[n][k], At[m][k], acc[ai][bj][m][n], 0, 0, 0); __builtin_amdgcn_s_setprio(0); } while (0)
#define PG8_WAIT_V(n) asm volatile("s_waitcnt vmcnt(" #n ")" ::: "memory")
#define PG8_WAIT_L(n) asm volatile("s_waitcnt lgkmcnt(" #n ")" ::: "memory")
#define PG8_BAR __builtin_amdgcn_s_barrier()
#define PG8_SCHED __builtin_amdgcn_sched_barrier(0)
    Unit cur, nxt; int ui = 0;
    if (!S.next(0, cur)) return;
    f32x4 acc[2][2][4][2];
#pragma unroll
    for (int a = 0; a < 2; ++a)
#pragma unroll
        for (int b = 0; b < 2; ++b)
#pragma unroll
            for (int m = 0; m < 4; ++m)
#pragma unroll
                for (int n = 0; n < 2; ++n) acc[a][b][m][n] = (f32x4){0.f, 0.f, 0.f, 0.f};
    h16x8 At[4][2], B0[2][2], B1[2][2];
    const char* cA = (const char*)g.A + (size_t)cur.pm * tstepA; const char* cB = (const char*)g.Bt + (size_t)cur.pn * tstepB;
    PG8_STAGE(PG8_SB(0, 0), cB, voffB); PG8_STAGE(PG8_SA(0, 0), cA, voffA); PG8_STAGE(PG8_SB(0, 1), cB + hstepB, voffB); PG8_STAGE(PG8_SA(0, 1), cA + hstepA, voffA);
    if (wr == 1) PG8_BAR;
    PG8_WAIT_V(4); PG8_BAR;
    PG8_STAGE(PG8_SB(1, 0), cB + kstep, voffB); PG8_STAGE(PG8_SA(1, 0), cA + kstep, voffA); PG8_STAGE(PG8_SB(1, 1), cB + hstepB + kstep, voffB);
    PG8_WAIT_V(6); PG8_BAR;
    for (;;) {
        const bool has_next = S.next(ui + 1, nxt);
        const char* nA = has_next ? (const char*)g.A + (size_t)nxt.pm * tstepA : cA; const char* nB = has_next ? (const char*)g.Bt + (size_t)nxt.pn * tstepB : cB;
        for (int t = 0; t < nt; t += 2) {
            const bool last = (t == nt - 2);
            const char* a1 = cA + (size_t)(t + 1) * kstep;
            const char* a2 = last ? nA : cA + (size_t)(t + 2) * kstep; const char* b2 = last ? nB : cB + (size_t)(t + 2) * kstep;
            const char* a3 = a2 + kstep; const char* b3 = b2 + kstep;
            PG8_LDB(B0, 0, 0); PG8_SCHED; PG8_LDA(At, 0, 0); PG8_STAGE(PG8_SA(1, 1), a1 + hstepA, voffA);
            PG8_WAIT_L(8); PG8_BAR; PG8_WAIT_L(0); PG8_MMA(0, 0, At, B0); PG8_BAR; PG8_SCHED;
            PG8_LDB(B1, 0, 1); PG8_STAGE(PG8_SB(0, 0), b2, voffB);
            PG8_BAR; PG8_WAIT_L(0); PG8_MMA(0, 1, At, B1); PG8_BAR;
            PG8_LDA(At, 0, 1); PG8_STAGE(PG8_SA(0, 0), a2, voffA);
            PG8_BAR; PG8_WAIT_L(0); PG8_MMA(1, 0, At, B0); PG8_BAR; PG8_SCHED;
            PG8_STAGE(PG8_SB(0, 1), b2 + hstepB, voffB);
            PG8_WAIT_V(6); PG8_BAR; PG8_MMA(1, 1, At, B1); PG8_BAR;
            PG8_LDB(B0, 1, 0); PG8_SCHED; PG8_LDA(At, 1, 0); PG8_STAGE(PG8_SA(0, 1), a2 + hstepA, voffA);
            PG8_WAIT_L(8); PG8_BAR; PG8_WAIT_L(0); PG8_MMA(0, 0, At, B0); PG8_BAR; PG8_SCHED;
            PG8_LDB(B1, 1, 1); PG8_STAGE(PG8_SB(1, 0), b3, voffB);
            PG8_BAR; PG8_WAIT_L(0); PG8_MMA(0, 1, At, B1); PG8_BAR;
            PG8_LDA(At, 1, 1); PG8_STAGE(PG8_SA(1, 0), a3, voffA);
            PG8_BAR; PG8_WAIT_L(0); PG8_MMA(1, 0, At, B0); PG8_BAR; PG8_SCHED;
            PG8_STAGE(PG8_SB(1, 1), b3 + hstepB, voffB);
            PG8_WAIT_V(6); PG8_BAR; PG8_MMA(1, 1, At, B1); PG8_BAR;
        }
        E(acc, cur, wr, wc, fr, fq);
        if (!has_next) break;
#pragma unroll
        for (int a = 0; a < 2; ++a)
#pragma unroll
            for (int b = 0; b < 2; ++b)
#pragma unroll
                for (int m = 0; m < 4; ++m)
#pragma unroll
                    for (int n = 0; n < 2; ++n) acc[a][b][m][n] = (f32x4){0.f, 0.f, 0.f, 0.f};
        cur = nxt; cA = nA; cB = nB; ++ui;
    }
    PG8_WAIT_V(0);
    if (wr == 0) PG8_BAR;
    PG8_BAR;
#undef PG8_SA
#undef PG8_SB
#undef PG8_STAGE
#undef PG8_LDA
#undef PG8_LDB
#undef PG8_MMA
#undef PG8_WAIT_V
#undef PG8_WAIT_L
#undef PG8_BAR
#undef PG8_SCHED
}

template <int MODE>
__device__ void run_gemm(unsigned char* smem, const h16* A, int lda, const h16* Bt, int M, int N, int K, void* o, const void* a1, const void* a2, int ldc, unsigned char* ws) {
    Gemm g; g.A = A; g.Bt = Bt; g.M = M; g.N = N; g.K = K; g.lda = lda;
    StaticOrder S; S.init(M, N, (int)gridDim.x, (int)blockIdx.x);
    Epi<MODE> E; E.o = o; E.a1 = a1; E.a2 = a2; E.ldc = ldc; E.ws = ws;
    gemm_phase<Epi<MODE>>((LAS unsigned char*)smem, g, S, E);
    __syncthreads();
}
}

__device__ __forceinline__ int win_src(int n) {
    if (n < 3072) return n;
    if (n < 5120) return n - 3072 + 3088;
    if (n < 5248) return n - 5120 + 5136;
    if (n < 5312) return n - 5248 + 5776;
    if (n < 5328) return n - 5312 + 3072;
    if (n < 5336) return n - 5328 + 5840;
    if (n < 5376) return -1;
    if (n < 5888) return n - 5376 + 5264;
    return n - 5888 + 5848;
}

__device__ void cvt_f32_to_h16(const float* src, h16* dst, size_t n) {
    const size_t n8 = n / 8;
    for (size_t i = (size_t)blockIdx.x * blockDim.x + threadIdx.x; i < n8; i += (size_t)gridDim.x * blockDim.x) {
        const f32x4 a = ((const f32x4*)src)[2 * i], b = ((const f32x4*)src)[2 * i + 1];
        ((h16x8*)dst)[i] = pack8(a, b);
    }
}

__device__ void phase_prep(const Params& P, unsigned char* smem) {
    const int tid = threadIdx.x;
    if (blockIdx.x == 0 && tid < 64) ((unsigned*)(P.ws + OFF_CTR))[tid] = 0u;
    cvt_f32_to_h16(P.x, (h16*)(P.ws + OFF_X16), (size_t)T_ * 1024);
    float* tile = (float*)smem;
    for (int tix = blockIdx.x; tix < 5184; tix += gridDim.x) {
        const float* src; h16* dst; int ldsrc, K, tilesK, id; bool isin = false;
        if (tix < 1984) { src = P.w_in; ldsrc = 7896; K = 1024; dst = (h16*)(P.ws + OFF_WIN); id = tix; isin = true; }
        else if (tix < 3392) { src = P.w_up; ldsrc = 5632; K = 1024; dst = (h16*)(P.ws + OFF_WUP); id = tix - 1984; }
        else if (tix < 4096) { src = P.w_down; ldsrc = 1024; K = 2816; dst = (h16*)(P.ws + OFF_WDOWN); id = tix - 3392; }
        else if (tix < 4352) { src = P.w_gla_proj; ldsrc = 1024; K = 1024; dst = (h16*)(P.ws + OFF_WGLA); id = tix - 4096; }
        else if (tix < 4608) { src = P.w_out; ldsrc = 1024; K = 1024; dst = (h16*)(P.ws + OFF_WOUT); id = tix - 4352; }
        else if (tix < 4864) { src = P.w_ple_gate; ldsrc = 1024; K = 1024; dst = (h16*)(P.ws + OFF_WPG); id = tix - 4608; }
        else if (tix < 4928) { src = P.w_ple; ldsrc = 1024; K = 256; dst = (h16*)(P.ws + OFF_WPLE); id = tix - 4864; }
        else { src = P.w_dsa_proj; ldsrc = 1024; K = 1024; dst = (h16*)(P.ws + OFF_WCOMB); id = tix - 4928; }
        tilesK = K / 64;
        const int tn = id / tilesK, tk = id % tilesK;
        {
            const int n4 = tid & 15, n = tn * 64 + 4 * n4; const int sc = isin ? win_src(n) : n;
#pragma unroll
            for (int i = 0; i < 2; ++i) { const int kk = (tid >> 4) + 32 * i;
                f32x4 v = {0.f, 0.f, 0.f, 0.f};
                if (sc >= 0) v = *(const f32x4*)(src + (size_t)(tk * 64 + kk) * ldsrc + sc);
                *(f32x4*)&tile[kk * 68 + 4 * n4] = v; }
        }
        __syncthreads();
        {
            const int nn = tid >> 3, k8 = tid & 7;
            h16x8 o;
#pragma unroll
            for (int j = 0; j < 8; ++j) o[j] = (h16)tile[(8 * k8 + j) * 68 + nn];
            *(h16x8*)(dst + (size_t)(tn * 64 + nn) * K + tk * 64 + 8 * k8) = o;
        }
        __syncthreads();
    }
    h16* wu = (h16*)(P.ws + OFF_WCOMB + 2 * MiB);
    for (int e = blockIdx.x * blockDim.x + tid; e < 16 * 64 * 128; e += gridDim.x * blockDim.x) {
        const int h = e >> 13, d = (e >> 7) & 63, c = e & 127;
        wu[e] = (h16)P.w_uv[(size_t)(h * 128 + c) * 64 + d];
    }
}

__device__ void gla_prep_item(const Params& P, unsigned char* smem, int item) {
    const int tid = threadIdx.x, lane = tid & 63, w = __builtin_amdgcn_readfirstlane(tid >> 6);
    const int b = item >> 7, n = item & 127; const size_t tb = (size_t)b * L_ + 64 * n;
    h16* GQ = (h16*)(P.ws + OFF_GQ); h16* GK = (h16*)(P.ws + OFF_GK); h16* GV = (h16*)(P.ws + OFF_GV);
    const h16* MISC = (const h16*)(P.ws + OFF_MISC); h16* ATTN = (h16*)(P.ws + OFF_ATTN); float* DECAY = (float*)(P.ws + OFF_DECAY);
    h16* KS = (h16*)smem; float* LA = (float*)(smem + 65536); h16* QI = (h16*)(smem + 98304); h16* KI = (h16*)(smem + 115712);
    float* GA = (float*)(smem + 133120); float* TOT = (float*)(smem + 137216);
#pragma unroll
    for (int i = 0; i < 8; ++i) { const int idx = tid + 512 * i; ((u32x4*)KS)[idx] = ((const u32x4*)(GK + tb * 512))[idx]; }
#pragma unroll
    for (int i = 0; i < 2; ++i) { const int idx = tid + 512 * i; GA[idx] = (float)MISC[(tb + (idx >> 4)) * 256 + 192 + (idx & 15)]; }
    __syncthreads();
    const int d = tid & 127, tq = tid >> 7;
    float wg[16], wgn[16], bias, biasn;
#pragma unroll
    for (int r = 0; r < 16; ++r) wg[r] = P.w_gate_up[r * 512 + d];
    bias = P.b_gate[d];
    for (int h = 0; h < 4; ++h) {
        const int hc = h * 128 + d;
        {
            const int hn = (h < 3 ? h + 1 : 3) * 128 + d;
#pragma unroll
            for (int r = 0; r < 16; ++r) wgn[r] = P.w_gate_up[r * 512 + hn];
            biasn = P.b_gate[hn];
        }
        float run = 0.f;
        for (int tt = 0; tt < 16; ++tt) {
            const int t = 16 * tq + tt; float z = bias;
#pragma unroll
            for (int r = 0; r < 16; ++r) z += GA[t * 16 + r] * wg[r];
            const float ls = (fminf(z, 0.f) - __logf(1.0f + __expf(-fabsf(z)))) * 0.0625f;
            run += ls; LA[t * 128 + d] = run;
        }
        TOT[tq * 128 + d] = run;
        __syncthreads();
        float off = 0.f, tot = 0.f;
#pragma unroll
        for (int q = 0; q < 4; ++q) { const float v = TOT[q * 128 + d]; tot += v; if (q < tq) off += v; }
        h16x8 ks0, ks1;
        h16 qh[16];
#pragma unroll
        for (int tt = 0; tt < 16; ++tt) qh[tt] = GQ[(tb + 16 * tq + tt) * 512 + hc];
#pragma unroll
        for (int tt = 0; tt < 16; ++tt) {
            const int t = 16 * tq + tt; const float bb = LA[t * 128 + d] + off;
            h16* qp = GQ + (tb + t) * 512 + hc;
            const float qi = (float)qh[tt] * 0.08838834764831845f * __expf(bb);
            *qp = (h16)qi; QI[t * 136 + d] = (h16)qi;
            const float k = (float)KS[t * 512 + hc];
            KI[t * 136 + d] = (h16)(k * __expf(-bb));
            const h16 kst = (h16)(k * __expf(tot - bb));
            if (tt < 8) ks0[tt] = kst; else ks1[tt - 8] = kst;
        }
        {
            h16* dst = GK + tb * 512 + (size_t)hc * 64 + 16 * tq;
            *(h16x8*)dst = ks0; *(h16x8*)(dst + 8) = ks1;
        }
        if (tq == 0) DECAY[((size_t)item * 4 + h) * 128 + d] = __expf(tot);
        __syncthreads();
        {
            const int it = w >> 1, n16 = lane & 15, g = lane >> 4;
#pragma unroll
            for (int jj = 0; jj < 2; ++jj) {
                const int jt = 2 * (w & 1) + jj;
                f32x4 acc = {0.f, 0.f, 0.f, 0.f};
                if (jt <= it) {
#pragma unroll
                    for (int ks = 0; ks < 4; ++ks) {
                        const h16x8 a = *(const h16x8*)&KI[(16 * jt + n16) * 136 + 32 * ks + 8 * g];
                        const h16x8 bq = *(const h16x8*)&QI[(16 * it + n16) * 136 + 32 * ks + 8 * g];
                        acc = __builtin_amdgcn_mfma_f32_16x16x32_f16(a, bq, acc, 0, 0, 0);
                    }
                }
                const int i = 16 * it + n16, j0 = 16 * jt + 4 * g;
                h16x4 o;
#pragma unroll
                for (int e = 0; e < 4; ++e) o[e] = (j0 + e <= i) ? (h16)acc[e] : (h16)0.f;
                *(h16x4*)(ATTN + ((size_t)item * 4 + h) * 4096 + i * 64 + j0) = o;
            }
        }
        __syncthreads();
#pragma unroll
        for (int r = 0; r < 16; ++r) wg[r] = wgn[r];
        bias = biasn;
    }
    h16* VT = (h16*)smem;
    u32x4 vcur[4], vnxt[4];
#pragma unroll
    for (int i = 0; i < 4; ++i) vcur[i] = ((const u32x4*)(GV + ((size_t)0 * T_ + tb) * 256))[tid + 512 * i];
    for (int h = 0; h < 4; ++h) {
        h16* src = GV + ((size_t)h * T_ + tb) * 256;
#pragma unroll
        for (int i = 0; i < 4; ++i) { const int idx = tid + 512 * i; *(u32x4*)&VT[(idx >> 5) * 264 + (idx & 31) * 8] = vcur[i]; }
        {
            const int hn = h < 3 ? h + 1 : 3;
#pragma unroll
            for (int i = 0; i < 4; ++i) vnxt[i] = ((const u32x4*)(GV + ((size_t)hn * T_ + tb) * 256))[tid + 512 * i];
        }
        asm volatile("s_waitcnt lgkmcnt(0)" ::: "memory"); __builtin_amdgcn_s_barrier(); asm volatile("" ::: "memory");
        {
            const int dv = tid >> 1, hf = tid & 1;
#pragma unroll
            for (int q = 0; q < 4; ++q) {
                h16x8 o;
#pragma unroll
                for (int j = 0; j < 8; ++j) o[j] = VT[(32 * hf + 8 * q + j) * 264 + dv];
                *(h16x8*)(src + (size_t)dv * 64 + 32 * hf + 8 * q) = o;
            }
        }
        asm volatile("s_waitcnt lgkmcnt(0)" ::: "memory"); __builtin_amdgcn_s_barrier(); asm volatile("" ::: "memory");
#pragma unroll
        for (int i = 0; i < 4; ++i) vcur[i] = vnxt[i];
    }
}

__device__ void phase_gla_prep(const Params& P, unsigned char* smem) {
    if (blockIdx.x == 0 && threadIdx.x < 256) ((unsigned*)(P.ws + OFF_CTR))[threadIdx.x] = 0u;
    {
        const int lane = threadIdx.x & 63, gw = blockIdx.x * 8 + (threadIdx.x >> 6), pc = lane & 15;
        const h16* MISC = (const h16*)(P.ws + OFF_MISC); h16* CK = (h16*)(P.ws + OFF_CKVC); h16* IK = (h16*)(P.ws + OFF_IKC);
        float gk[8];
#pragma unroll
        for (int k = 0; k < 8; ++k) gk[k] = P.g_ckv[8 * pc + k];
        for (int r4 = gw; r4 < T_ / 4; r4 += gridDim.x * 8) {
            const int r = 4 * r4 + (lane >> 4);
            const h16x8 v = *(const h16x8*)(MISC + (size_t)r * 256 + 8 * pc);
            u32x4 ikv; if (pc < 8) ikv = *(const u32x4*)(MISC + (size_t)r * 256 + 128 + 8 * pc);
            float ss = 0.f;
#pragma unroll
            for (int k = 0; k < 8; ++k) ss += (float)v[k] * (float)v[k];
            ss += __shfl_xor(ss, 1); ss += __shfl_xor(ss, 2); ss += __shfl_xor(ss, 4); ss += __shfl_xor(ss, 8);
            const float rs = rsqrtf(ss * (1.0f / 128.0f) + LN_EPS);
            h16x8 ov;
#pragma unroll
            for (int k = 0; k < 8; ++k) ov[k] = (h16)((float)v[k] * rs * gk[k]);
            *(h16x8*)(CK + (size_t)r * 128 + 8 * pc) = ov;
            if (pc < 8) *(u32x4*)(IK + (size_t)r * 64 + 8 * pc) = ikv;
        }
    }
    for (int item = blockIdx.x; item < 512; item += gridDim.x) gla_prep_item(P, smem, item);
}

__device__ void gla_rec(const Params& P, unsigned char* smem, int wg) {
    const int tid = threadIdx.x, lane = tid & 63, w = __builtin_amdgcn_readfirstlane(tid >> 6), n16 = lane & 15, g = lane >> 4;
    const int b = wg >> 2, h = wg & 3;
    const h16* GQ = (const h16*)(P.ws + OFF_GQ); const h16* GK = (const h16*)(P.ws + OFF_GK); const h16* GV = (const h16*)(P.ws + OFF_GV);
    const h16* GR = (const h16*)(P.ws + OFF_GR); h16* OA = (h16*)(P.ws + OFF_X16); const h16* ATTN = (const h16*)(P.ws + OFF_ATTN); const float* DECAY = (const float*)(P.ws + OFF_DECAY);
    constexpr int A_OFF = 0, Q_OFF = 9216, K_OFF = 26624, D_OFF = 45056, BUF = 45568, O_OFF = 2 * BUF;
    f32x4 S[8][2];
#pragma unroll
    for (int mt = 0; mt < 8; ++mt) { S[mt][0] = (f32x4){0.f, 0.f, 0.f, 0.f}; S[mt][1] = (f32x4){0.f, 0.f, 0.f, 0.f}; }
    const int piece = tid & 31;
    float gnv[8];
#pragma unroll
    for (int k = 0; k < 8; ++k) gnv[k] = P.g_gla[h * 256 + piece * 8 + k];
    u32x4 st[5], dcy; h16x8 bV[2][2], bVn[2][2];
    auto issue = [&](int n, h16x8 (&bv)[2][2]) {
        const int item = b * 128 + n; const size_t ch = (size_t)item * 4 + h; const size_t tb = (size_t)b * L_ + 64 * n;
        const h16* at = ATTN + ch * 4096;
        const h16* vt = GV + ((size_t)h * T_ + tb) * 256 + (size_t)(32 * w) * 64;
        const h16* qi = GQ + tb * 512 + h * 128;
        const h16* kt = GK + tb * 512 + (size_t)h * 128 * 64;
        const float* dc = DECAY + ch * 128;
        st[0] = *(const u32x4*)(at + (tid >> 3) * 64 + (tid & 7) * 8);
#pragma unroll
        for (int i = 1; i < 3; ++i) { const int cc = tid + 512 * (i - 1); st[i] = *(const u32x4*)(qi + (size_t)(cc >> 4) * 512 + (cc & 15) * 8); }
#pragma unroll
        for (int i = 3; i < 5; ++i) { const int cc = tid + 512 * (i - 3); st[i] = *(const u32x4*)(kt + (size_t)(cc >> 3) * 64 + (cc & 7) * 8); }
        if (tid < 32) dcy = *(const u32x4*)(dc + tid * 4);
#pragma unroll
        for (int ct = 0; ct < 2; ++ct)
#pragma unroll
            for (int ks = 0; ks < 2; ++ks) bv[ct][ks] = *(const h16x8*)(vt + (16 * ct + n16) * 64 + 32 * ks + 8 * g);
    };
    auto commit = [&](int buf) {
        unsigned char* Bn = smem + buf * BUF;
        *(u32x4*)(Bn + A_OFF + (tid >> 3) * 144 + (tid & 7) * 16) = st[0];
#pragma unroll
        for (int i = 1; i < 3; ++i) { const int cc = tid + 512 * (i - 1); *(u32x4*)(Bn + Q_OFF + (cc >> 4) * 272 + (cc & 15) * 16) = st[i]; }
#pragma unroll
        for (int i = 3; i < 5; ++i) { const int cc = tid + 512 * (i - 3); *(u32x4*)(Bn + K_OFF + (cc >> 3) * 144 + (cc & 7) * 16) = st[i]; }
        if (tid < 32) *(u32x4*)(Bn + D_OFF + tid * 16) = dcy;
    };
    issue(0, bV); commit(0);
    __syncthreads();
    for (int n = 0; n < 128; ++n) {
        const size_t tb = (size_t)b * L_ + 64 * n;
        issue(n < 127 ? n + 1 : n, bVn);
        u32x4 grr[4];
#pragma unroll
        for (int j = 0; j < 4; ++j) grr[j] = *(const u32x4*)(GR + (tb + (tid >> 5) + 16 * j) * 1024 + h * 256 + piece * 8);
        const unsigned char* B = smem + (n & 1) * BUF;
        h16x8 sB[2][4];
#pragma unroll
        for (int ct = 0; ct < 2; ++ct)
#pragma unroll
            for (int ks = 0; ks < 4; ++ks) sB[ct][ks] = pack8(S[2 * ks][ct], S[2 * ks + 1][ct]);
#pragma unroll
        for (int tt = 0; tt < 4; ++tt) {
            const int i = 16 * tt + n16;
            h16x8 aA[2], aQ[4];
#pragma unroll
            for (int ks = 0; ks < 2; ++ks) aA[ks] = *(const h16x8*)(B + A_OFF + i * 144 + (32 * ks + 8 * g) * 2);
#pragma unroll
            for (int ks = 0; ks < 4; ++ks) {
                const h16x4 lo = *(const h16x4*)(B + Q_OFF + i * 272 + (32 * ks + 4 * g) * 2), hi = *(const h16x4*)(B + Q_OFF + i * 272 + (32 * ks + 16 + 4 * g) * 2);
                aQ[ks] = (h16x8){lo[0], lo[1], lo[2], lo[3], hi[0], hi[1], hi[2], hi[3]};
            }
#pragma unroll
            for (int ct = 0; ct < 2; ++ct) {
                f32x4 acc = {0.f, 0.f, 0.f, 0.f};
#pragma unroll
                for (int ks = 0; ks < 2; ++ks) acc = __builtin_amdgcn_mfma_f32_16x16x32_f16(aA[ks], bV[ct][ks], acc, 0, 0, 0);
#pragma unroll
                for (int ks = 0; ks < 4; ++ks) acc = __builtin_amdgcn_mfma_f32_16x16x32_f16(aQ[ks], sB[ct][ks], acc, 0, 0, 0);
#pragma unroll
                for (int e = 0; e < 4; ++e) *(h16*)(smem + O_OFF + (16 * tt + 4 * g + e) * 528 + (32 * w + 16 * ct + n16) * 2) = (h16)acc[e];
            }
        }
#pragma unroll
        for (int mt = 0; mt < 8; ++mt) {
            const f32x4 dcv = *(const f32x4*)(B + D_OFF + (16 * mt + 4 * g) * 4);
            h16x8 aK[2];
#pragma unroll
            for (int ks = 0; ks < 2; ++ks) aK[ks] = *(const h16x8*)(B + K_OFF + (16 * mt + n16) * 144 + (32 * ks + 8 * g) * 2);
#pragma unroll
            for (int ct = 0; ct < 2; ++ct) {
                f32x4 acc = S[mt][ct] * dcv;
#pragma unroll
                for (int ks = 0; ks < 2; ++ks) acc = __builtin_amdgcn_mfma_f32_16x16x32_f16(aK[ks], bV[ct][ks], acc, 0, 0, 0);
                S[mt][ct] = acc;
            }
        }
        commit((n + 1) & 1);
        __syncthreads();
#pragma unroll
        for (int j = 0; j < 4; ++j) {
            const int tok = (tid >> 5) + 16 * j;
            const h16x8 ov = *(const h16x8*)(smem + O_OFF + tok * 528 + piece * 16);
            float ss = 0.f;
#pragma unroll
            for (int k = 0; k < 8; ++k) ss += (float)ov[k] * (float)ov[k];
            ss += __shfl_xor(ss, 1); ss += __shfl_xor(ss, 2); ss += __shfl_xor(ss, 4); ss += __shfl_xor(ss, 8); ss += __shfl_xor(ss, 16);
            const float rs = rsqrtf(ss * (1.0f / 256.0f) + LN_EPS);
            const h16x8 gr8 = __builtin_bit_cast(h16x8, grr[j]);
            h16x8 r;
#pragma unroll
            for (int k = 0; k < 8; ++k) r[k] = (h16)((float)ov[k] * rs * gnv[k] * siluf_((float)gr8[k]));
            *(h16x8*)(OA + (tb + tok) * 1024 + h * 256 + piece * 8) = r;
        }
        __syncthreads();
#pragma unroll
        for (int ct = 0; ct < 2; ++ct)
#pragma unroll
            for (int ks = 0; ks < 2; ++ks) bV[ct][ks] = bVn[ct][ks];
    }
}

__device__ __forceinline__ int score_bin(float sc) {
    const h16 hs = (h16)sc;
    const unsigned bits = (unsigned)__builtin_bit_cast(unsigned short, hs);
    const unsigned s16 = bits ^ ((bits & 0x8000u) ? 0xFFFFu : 0x8000u);
    return (int)(s16 >> 6);
}

constexpr int CAPC = 640;
constexpr int DS_HIST = 0, DS_CANDI = 32768, DS_SEL = 69632, DS_CANDS = 77824, DS_KST = 118784, DS_META = 155648, DS_SLOT = 156672, DS_WL = 157696, DS_OST = 77824;

__device__ __forceinline__ h16 bin_edge(int b) {
    if (b < 0) return __builtin_bit_cast(h16, (unsigned short)0xFC00u);
    const unsigned s16 = (unsigned)b << 6;
    const unsigned bits = (s16 & 0x8000u) ? (s16 ^ 0x8000u) : (~s16 & 0xFFFFu);
    return __builtin_bit_cast(h16, (unsigned short)bits);
}

template <int PASS>
__device__ __forceinline__ void dsa_pass(const h16* IKC, unsigned char* smem, int tid, int b, int t0, int nkt, int step, int a0, int ktl, int lane, const h16x8 (&af)[2][4]) {
    unsigned* HIST = (unsigned*)(smem + DS_HIST); float* CANDS = (float*)(smem + DS_CANDS); unsigned short* CANDI = (unsigned short*)(smem + DS_CANDI); int* META = (int*)(smem + DS_META);
    const int half = lane >> 5, r = lane & 31;
    h16 lo[2][2] = {{(h16)0.f, (h16)0.f}, {(h16)0.f, (h16)0.f}};
    if (PASS == 2) {
#pragma unroll
        for (int u = 0; u < 2; ++u) { lo[u][0] = bin_edge(META[4 * (a0 + u) + 2 * half]); lo[u][1] = bin_edge(META[4 * (a0 + u) + 2 * half + 1]); }
    }
    unsigned char* KST = smem + DS_KST;
    const int nst = (nkt + 3) >> 2;
    const int J = (nst + step - 1) / step;
    auto epilogue = [&](int kt, const f32x16& acc, const int u) {
        const int s = 32 * kt + r;
        const int qa0 = 4 * (a0 + u) + 2 * half, qa1 = qa0 + 1; const h16 lo0 = lo[u][0], lo1 = lo[u][1];
        float p[4];
#pragma unroll
        for (int m = 0; m < 4; ++m) { float v = 0.f;
            const f32x4 w4 = *(const f32x4*)(smem + DS_WL + ((4 * (a0 + u) + m) * 2 + half) * 16);
#pragma unroll
            for (int j = 0; j < 4; ++j) { const int ri = __float_as_int(acc[4 * j + m]); v = __builtin_fmaf(w4[j], __int_as_float(ri > 0 ? ri : 0), v); }
            p[m] = v; }
        const auto r02 = __builtin_amdgcn_permlane32_swap(__float_as_uint(p[0]), __float_as_uint(p[2]), false, false);
        const auto r13 = __builtin_amdgcn_permlane32_swap(__float_as_uint(p[1]), __float_as_uint(p[3]), false, false);
        const float sc0 = (__uint_as_float(r02[0]) + __uint_as_float(r02[1])) + 0.0f;
        const float sc1 = (__uint_as_float(r13[0]) + __uint_as_float(r13[1])) + 0.0f;
        const bool v0 = s <= t0 + qa0, v1 = s <= t0 + qa1;
        if (PASS == 1) {
            const int b0 = score_bin(sc0), b1 = score_bin(sc1);
            if (v0) atomicAdd(&HIST[qa0 * 512 + (b0 >> 1)], 1u << (16 * (b0 & 1)));
            if (v1) atomicAdd(&HIST[qa1 * 512 + (b1 >> 1)], 1u << (16 * (b1 & 1)));
        } else {
            if (v0 && (h16)sc0 >= lo0) { const int pos = atomicAdd(&META[48 + qa0], 1); if (pos < CAPC) { CANDS[qa0 * CAPC + pos] = sc0; CANDI[qa0 * CAPC + pos] = (unsigned short)s; } }
            if (v1 && (h16)sc1 >= lo1) { const int pos = atomicAdd(&META[48 + qa1], 1); if (pos < CAPC) { CANDS[qa1 * CAPC + pos] = sc1; CANDI[qa1 * CAPC + pos] = (unsigned short)s; } }
        }
    };
    auto gload = [&](int j, u32x4 (&rg)[2]) {
        if (j > J - 1) j = J - 1;
        const int st = j * step;
#pragma unroll
        for (int i = 0; i < 2; ++i) { const int id = tid + 512 * i; rg[i] = *(const u32x4*)(IKC + ((size_t)b * L_ + 128 * st + (id >> 3)) * 64 + (id & 7) * 8); }
    };
    auto lstore = [&](int buf, const u32x4 (&rg)[2]) {
#pragma unroll
        for (int i = 0; i < 2; ++i) { const int id = tid + 512 * i; *(u32x4*)(KST + buf * 18432 + (id >> 3) * 144 + (id & 7) * 16) = rg[i]; }
    };
    auto stage = [&](int j, int buf) {
        const int st = j * step;
        f32x16 acc[2];
#pragma unroll
        for (int u = 0; u < 2; ++u)
#pragma unroll
            for (int i = 0; i < 16; ++i) acc[u][i] = 0.f;
        h16x8 bfr[4];
#pragma unroll
        for (int ks = 0; ks < 4; ++ks) bfr[ks] = *(const h16x8*)(KST + buf * 18432 + (32 * ktl + r) * 144 + (32 * ks + 16 * half));
        __builtin_amdgcn_s_setprio(1);
#pragma unroll
        for (int ks = 0; ks < 4; ++ks) {
#pragma unroll
            for (int u = 0; u < 2; ++u) acc[u] = __builtin_amdgcn_mfma_f32_32x32x16_f16(af[u][ks], bfr[ks], acc[u], 0, 0, 0);
        }
        __builtin_amdgcn_s_setprio(0);
#pragma unroll
        for (int u = 0; u < 2; ++u) epilogue(4 * st + ktl, acc[u], u);
    };
    u32x4 rg[3][2];
#define LDS_BARRIER() do { asm volatile("s_waitcnt lgkmcnt(0)" ::: "memory"); __builtin_amdgcn_s_barrier(); asm volatile("" ::: "memory"); } while (0)
    gload(0, rg[0]); lstore(0, rg[0]);
#pragma unroll
    for (int i = 0; i < 3; ++i) gload(i + 1, rg[i]);
    LDS_BARRIER();
    for (int k = 0; k < J; k += 6) {
        stage(k, 0); lstore(1, rg[0]); gload(k + 4, rg[0]);
        LDS_BARRIER();
        if (k + 1 >= J) break;
        stage(k + 1, 1); lstore(0, rg[1]); gload(k + 5, rg[1]);
        LDS_BARRIER();
        if (k + 2 >= J) break;
        stage(k + 2, 0); lstore(1, rg[2]); gload(k + 6, rg[2]);
        LDS_BARRIER();
        if (k + 3 >= J) break;
        stage(k + 3, 1); lstore(0, rg[0]); gload(k + 7, rg[0]);
        LDS_BARRIER();
        if (k + 4 >= J) break;
        stage(k + 4, 0); lstore(1, rg[1]); gload(k + 8, rg[1]);
        LDS_BARRIER();
        if (k + 5 >= J) break;
        stage(k + 5, 1); lstore(0, rg[2]); gload(k + 9, rg[2]);
        LDS_BARRIER();
    }
#undef LDS_BARRIER
}

__device__ __forceinline__ void hist_threshold(const unsigned* row, int lane, int R, int& thr, int& above, int& total) {
    unsigned wd[8]; int c = 0;
#pragma unroll
    for (int i = 0; i < 8; ++i) { wd[i] = row[504 - 8 * lane + i]; c += (int)(wd[i] & 0xFFFFu) + (int)(wd[i] >> 16); }
    int pre = c;
#pragma unroll
    for (int off = 1; off < 64; off <<= 1) { const int t = __shfl_up(pre, off); if (lane >= off) pre += t; }
    const int excl = pre - c;
    total = __shfl(pre, 63);
    int mythr = -1, myabove = 0;
    const bool hit = (pre >= R && excl < R);
    if (hit) {
        int cum = excl; bool done = false;
#pragma unroll
        for (int i = 7; i >= 0; --i) {
            const int chi = (int)(wd[i] >> 16), clo = (int)(wd[i] & 0xFFFFu);
            const int binhi = 2 * (504 - 8 * lane + i) + 1;
            if (!done) { if (cum + chi >= R) { mythr = binhi; myabove = cum; done = true; } else cum += chi; }
            if (!done) { if (cum + clo >= R) { mythr = binhi - 1; myabove = cum; done = true; } else cum += clo; }
        }
    }
    const unsigned long long m = __ballot(hit);
    if (m) { const int src = __ffsll((long long)m) - 1; thr = __shfl(mythr, src); above = __shfl(myabove, src); }
    else { thr = -1; above = 0; }
}

__device__ void dsa_tile(const Params& P, unsigned char* smem, int item) {
    const int tid = threadIdx.x, lane = tid & 63, w = __builtin_amdgcn_readfirstlane(tid >> 6);
    const int b = item & 3, qt = 511 - (item >> 2), t0 = qt * 16;
    const int nkt = (t0 + 16 + 31) >> 5;
    const h16* MISC = (const h16*)(P.ws + OFF_MISC); const h16* IQ = (const h16*)(P.ws + OFF_IQ); h16* DQ = (h16*)(P.ws + OFF_DQ);
    const h16* CKVC = (const h16*)(P.ws + OFF_CKVC); const h16* IKC = (const h16*)(P.ws + OFF_IKC);
    unsigned* HIST = (unsigned*)(smem + DS_HIST); float* CANDS = (float*)(smem + DS_CANDS); unsigned short* CANDI = (unsigned short*)(smem + DS_CANDI);
    unsigned short* SEL = (unsigned short*)(smem + DS_SEL); int* META = (int*)(smem + DS_META);
    const int a0 = 2 * (w & 1), ktl = w >> 1;
    h16x8 af[2][4];
    {
        const int half = lane >> 5, r = lane & 31, qloc = r & 3, hh = r >> 2;
#pragma unroll
        for (int u = 0; u < 2; ++u) {
            const size_t tokA = (size_t)b * L_ + t0 + 4 * (a0 + u) + qloc;
#pragma unroll
            for (int ks = 0; ks < 4; ++ks) af[u][ks] = *(const h16x8*)(IQ + tokA * 512 + hh * 64 + 16 * ks + 8 * half);
        }
        if (tid < 128) { const int q = tid >> 3, hf = (tid >> 2) & 1, j = tid & 3;
            ((float*)(smem + DS_WL))[tid] = (float)MISC[((size_t)b * L_ + t0 + q) * 256 + 208 + 2 * j + hf] * 2.82842712474619f; }
    }
    const bool need_hist = (t0 + 16 > CAPC);
    for (int attempt = 0; attempt < 2; ++attempt) {
        const int step = attempt ? 1 : 4;
#pragma unroll
        for (int i = 0; i < 16; ++i) HIST[tid + 512 * i] = 0u;
        if (tid < 128) META[tid] = 0;
        __syncthreads();
        if (need_hist) {
            dsa_pass<1>(IKC, smem, tid, b, t0, nkt, step, a0, ktl, lane, af);
            __syncthreads();
        }
        for (int qq = 0; qq < 2; ++qq) {
            const int q = 2 * w + qq; const int nvalid = t0 + q + 1;
            int lo = -1;
            if (need_hist && nvalid > CAPC) {
                int thr, above, total;
                hist_threshold(HIST + q * 512, lane, 1, thr, above, total);
                int R = attempt ? 256 : (384 * total + nvalid - 1) / nvalid;
                if (R < 1) R = 1;
                hist_threshold(HIST + q * 512, lane, R, thr, above, total);
                lo = thr;
            }
            if (lane == 0) META[q] = lo;
        }
        __syncthreads();
        dsa_pass<2>(IKC, smem, tid, b, t0, nkt, 1, a0, ktl, lane, af);
        __syncthreads();
        if (tid < 16) {
            const int nvalid = t0 + tid + 1, K = nvalid < 256 ? nvalid : 256, cnt = META[48 + tid];
            if (cnt < K || (cnt > CAPC && attempt == 0)) atomicOr(&META[64], 1);
        }
        __syncthreads();
        const int fail = META[64];
        if (fail == 0 || attempt == 1) break;
        __syncthreads();
    }
    for (int qq = 0; qq < 2; ++qq) {
        const int q = 2 * w + qq; const int nvalid = t0 + q + 1, K = nvalid < 256 ? nvalid : 256;
        int C = META[48 + q]; if (C > CAPC) C = CAPC;
        unsigned* row = HIST + q * 512;
#pragma unroll
        for (int i = 0; i < 8; ++i) row[lane + 64 * i] = 0u;
        for (int i = lane; i < C; i += 64) { const int bin = score_bin(CANDS[q * CAPC + i]); atomicAdd(&row[bin >> 1], 1u << (16 * (bin & 1))); }
        int thr, above, total;
        hist_threshold(row, lane, K, thr, above, total);
        float* SMS = (float*)row; unsigned short* SMI = (unsigned short*)(row + 256);
        for (int i = lane; i < C; i += 64) {
            const float sc = CANDS[q * CAPC + i]; const unsigned short idx = CANDI[q * CAPC + i]; const int bin = score_bin(sc);
            if (bin > thr) { const int pos = atomicAdd(&META[32 + q], 1); if (pos < 256) SEL[q * 256 + pos] = idx; }
            else if (bin == thr) { const int pos = atomicAdd(&META[80 + q], 1); if (pos < 256) { SMS[pos] = sc; SMI[pos] = idx; } }
        }
        int Cb = META[80 + q]; if (Cb > 256) Cb = 256;
        const int need = K - above;
        for (int i = lane; i < Cb; i += 64) {
            const float si = SMS[i]; const int ii = SMI[i];
            int rank = 0;
            for (int j = 0; j < Cb; ++j) { const float sj = SMS[j]; const int ij = SMI[j]; rank += (sj > si || (sj == si && ij < ii)) ? 1 : 0; }
            if (rank < need) { const int pos = atomicAdd(&META[32 + q], 1); if (pos < 256) SEL[q * 256 + pos] = (unsigned short)ii; }
        }
        int cnt = META[32 + q]; if (cnt > 256) cnt = 256;
        for (int i = lane; i < 256; i += 64) if (i >= cnt) SEL[q * 256 + i] = 0xFFFFu;
    }
    __syncthreads();
    unsigned char* stage = smem + w * 8704;
    const int n16 = lane & 15, g = lane >> 4;
    for (int qq = 0; qq < 2; ++qq) {
        const int q = 2 * w + qq; const size_t tok = (size_t)b * L_ + t0 + q;
        int cnt = META[32 + q]; if (cnt > 256) cnt = 256;
        h16x8 qf[4];
#pragma unroll
        for (int ks = 0; ks < 4; ++ks) qf[ks] = *(const h16x8*)(DQ + tok * 2048 + n16 * 128 + 32 * ks + 8 * g);
        float m_run = -1e30f, l_run = 0.f;
        f32x4 oacc[8];
#pragma unroll
        for (int c8 = 0; c8 < 8; ++c8) oacc[c8] = (f32x4){0.f, 0.f, 0.f, 0.f};
        u32x4 gvA[8], gvB[8];
        auto gather = [&](int c, u32x4 (&gv)[8]) {
#pragma unroll
            for (int i = 0; i < 8; ++i) {
                const int row = 4 * i + g; const unsigned idx = SEL[q * 256 + 32 * c + row]; const unsigned key = (idx == 0xFFFFu) ? 0u : idx;
                gv[i] = *(const u32x4*)(CKVC + ((size_t)b * L_ + key) * 128 + n16 * 8);
            }
        };
        auto chunk = [&](int c, u32x4 (&gv)[8]) {
            asm volatile("" ::: "memory");
#pragma unroll
            for (int i = 0; i < 8; ++i) *(u32x4*)(stage + (4 * i + g) * 272 + n16 * 16) = gv[i];
            asm volatile("s_waitcnt lgkmcnt(0)" ::: "memory");
            gather(c + 2 < 8 ? c + 2 : 7, gv);
            f32x4 sacc[2];
#pragma unroll
            for (int k2 = 0; k2 < 2; ++k2) {
                f32x4 acc = {0.f, 0.f, 0.f, 0.f};
#pragma unroll
                for (int ks = 0; ks < 4; ++ks) { const h16x8 av = *(const h16x8*)(stage + (16 * k2 + n16) * 272 + (32 * ks + 8 * g) * 2); acc = __builtin_amdgcn_mfma_f32_16x16x32_f16(av, qf[ks], acc, 0, 0, 0); }
                sacc[k2] = acc;
            }
            float lg[2][4]; float cmax = -1e30f;
#pragma unroll
            for (int k2 = 0; k2 < 2; ++k2)
#pragma unroll
                for (int e = 0; e < 4; ++e) { float l = sacc[k2][e] * 0.08838834764831845f;
                    if (cnt < 256) { const int kpos = 32 * c + 16 * k2 + 4 * g + e; l = (kpos < cnt) ? l : -1e30f; }
                    lg[k2][e] = l; cmax = fmaxf(cmax, l); }
            cmax = fmaxf(cmax, __shfl_xor(cmax, 16)); cmax = fmaxf(cmax, __shfl_xor(cmax, 32));
            if (!__all(cmax - m_run <= 8.0f)) {
                const float m_new = fmaxf(m_run, cmax); const float corr = __expf(m_run - m_new);
#pragma unroll
                for (int c8 = 0; c8 < 8; ++c8) oacc[c8] = oacc[c8] * corr;
                l_run *= corr; m_run = m_new;
            }
            float psum = 0.f; f32x4 p0, p1;
#pragma unroll
            for (int e = 0; e < 4; ++e) { p0[e] = __expf(lg[0][e] - m_run); p1[e] = __expf(lg[1][e] - m_run); psum += p0[e] + p1[e]; }
            l_run += psum;
            const h16x8 pb = pack8(p0, p1);
            __builtin_amdgcn_s_setprio(1);
#pragma unroll
            for (int c8 = 0; c8 < 8; ++c8) {
                const LAS unsigned char* ad = (const LAS unsigned char*)(stage + (4 * g + (n16 >> 2)) * 272 + c8 * 32 + 8 * (n16 & 3));
                const v4s lo = __builtin_amdgcn_ds_read_tr16_b64_v4i16((LAS v4s*)ad);
                const v4s hi = __builtin_amdgcn_ds_read_tr16_b64_v4i16((LAS v4s*)(ad + 16 * 272));
                const h16x4 l4 = __builtin_bit_cast(h16x4, lo), h4 = __builtin_bit_cast(h16x4, hi);
                const h16x8 av = (h16x8){l4[0], l4[1], l4[2], l4[3], h4[0], h4[1], h4[2], h4[3]};
                oacc[c8] = __builtin_amdgcn_mfma_f32_16x16x32_f16(av, pb, oacc[c8], 0, 0, 0);
            }
            __builtin_amdgcn_s_setprio(0);
            asm volatile("s_waitcnt lgkmcnt(0)" ::: "memory");
        };
        gather(0, gvA); gather(1, gvB);
        for (int c = 0; c < 8; c += 2) { chunk(c, gvA); chunk(c + 1, gvB); }
        float lt = l_run; lt += __shfl_xor(lt, 16); lt += __shfl_xor(lt, 32);
        const float inv = 1.0f / lt;
#pragma unroll
        for (int c8 = 0; c8 < 8; ++c8) {
            h16x4 ov;
#pragma unroll
            for (int e = 0; e < 4; ++e) ov[e] = (h16)(oacc[c8][e] * inv);
            *(h16x4*)(smem + DS_OST + (n16 * 16 + q) * 272 + (16 * c8 + 4 * g) * 2) = ov;
        }
    }
    __syncthreads();
    {
        const h16* WUVT = (const h16*)(P.ws + OFF_WCOMB + 2 * MiB);
#pragma unroll
        for (int hh = 0; hh < 2; ++hh) {
            const int h = 2 * w + hh;
            h16x8 bq[4];
#pragma unroll
            for (int ks = 0; ks < 4; ++ks) bq[ks] = *(const h16x8*)(smem + DS_OST + (h * 16 + n16) * 272 + (32 * ks + 8 * g) * 2);
#pragma unroll
            for (int nt = 0; nt < 4; ++nt) {
                f32x4 acc = {0.f, 0.f, 0.f, 0.f};
#pragma unroll
                for (int ks = 0; ks < 4; ++ks) { const h16x8 av = *(const h16x8*)(WUVT + (size_t)(h * 64 + 16 * nt + n16) * 128 + 32 * ks + 8 * g); acc = __builtin_amdgcn_mfma_f32_16x16x32_f16(av, bq[ks], acc, 0, 0, 0); }
                h16x4 ov; ov[0] = (h16)acc[0]; ov[1] = (h16)acc[1]; ov[2] = (h16)acc[2]; ov[3] = (h16)acc[3];
                *(h16x4*)(DQ + ((size_t)b * L_ + t0 + n16) * 2048 + h * 64 + 16 * nt + 4 * g) = ov;
            }
        }
    }
    __syncthreads();
}

__device__ void phase_mixers(const Params& P, unsigned char* smem) {
    if (blockIdx.x < 16) for (int rep = 0; rep <= P.pad1; ++rep) gla_rec(P, smem, blockIdx.x);
    __syncthreads();
    unsigned* ctr = (unsigned*)(P.ws + OFF_CTR);
    int* slot = (int*)(smem + DS_SLOT);
    const int b0 = ((int)blockIdx.x & 7) >> 1;
    for (int bi = 0; bi < 4; ++bi) {
        const int b = (b0 + bi) & 3;
        for (;;) {
            if (threadIdx.x == 0) *slot = (int)atomicAdd(ctr + 64 * b, 1u);
            __syncthreads();
            const int it = *slot;
            __syncthreads();
            if (it >= 512) break;
            dsa_tile(P, smem, it * 4 + b);
        }
    }
}

__device__ void ln_rows(const float* v, const float* g, const float* bb, h16* o16, float* o32) {
    const int lane = threadIdx.x & 63, gw = blockIdx.x * 8 + (threadIdx.x >> 6);
    f32x4 gg[4], bv[4];
#pragma unroll
    for (int i = 0; i < 4; ++i) { gg[i] = ((const f32x4*)g)[lane + 64 * i]; bv[i] = ((const f32x4*)bb)[lane + 64 * i]; }
    for (int r = gw; r < T_; r += gridDim.x * 8) {
        const f32x4* rp = (const f32x4*)(v + (size_t)r * 1024);
        f32x4 a[4]; float s = 0.f;
#pragma unroll
        for (int i = 0; i < 4; ++i) { a[i] = rp[lane + 64 * i]; s += (a[i][0] + a[i][1]) + (a[i][2] + a[i][3]); }
#pragma unroll
        for (int o = 32; o >= 1; o >>= 1) s += __shfl_xor(s, o);
        const float mean = s * (1.0f / 1024.0f);
        float q = 0.f;
#pragma unroll
        for (int i = 0; i < 4; ++i) { a[i] = a[i] - mean; q += (a[i][0] * a[i][0] + a[i][1] * a[i][1]) + (a[i][2] * a[i][2] + a[i][3] * a[i][3]); }
#pragma unroll
        for (int o = 32; o >= 1; o >>= 1) q += __shfl_xor(q, o);
        const float rstd = rsqrtf(q * (1.0f / 1024.0f) + LN_EPS);
#pragma unroll
        for (int i = 0; i < 4; ++i) {
            const f32x4 y = a[i] * rstd * gg[i] + bv[i];
            if (o16) { h16x4 hv; hv[0] = (h16)y[0]; hv[1] = (h16)y[1]; hv[2] = (h16)y[2]; hv[3] = (h16)y[3]; ((h16x4*)(o16 + (size_t)r * 1024))[lane + 64 * i] = hv; }
            else ((f32x4*)(o32 + (size_t)r * 1024))[lane + 64 * i] = y;
        }
    }
}

__device__ void ln_rows16(h16* v, const float* g, const float* bb) {
    const int lane = threadIdx.x & 63, gw = blockIdx.x * 8 + (threadIdx.x >> 6);
    f32x4 gg[4], bv[4];
#pragma unroll
    for (int i = 0; i < 4; ++i) { gg[i] = ((const f32x4*)g)[4 * lane + i]; bv[i] = ((const f32x4*)bb)[4 * lane + i]; }
    for (int r = gw; r < T_; r += gridDim.x * 8) {
        h16x8* rp = (h16x8*)(v + (size_t)r * 1024 + 16 * lane);
        const h16x8 h0 = rp[0], h1 = rp[1];
        float a[16]; float s = 0.f;
#pragma unroll
        for (int k = 0; k < 8; ++k) { a[k] = (float)h0[k]; a[8 + k] = (float)h1[k]; }
#pragma unroll
        for (int k = 0; k < 16; ++k) s += a[k];
#pragma unroll
        for (int o = 32; o >= 1; o >>= 1) s += __shfl_xor(s, o);
        const float mean = s * (1.0f / 1024.0f);
        float q = 0.f;
#pragma unroll
        for (int k = 0; k < 16; ++k) { a[k] -= mean; q += a[k] * a[k]; }
#pragma unroll
        for (int o = 32; o >= 1; o >>= 1) q += __shfl_xor(q, o);
        const float rstd = rsqrtf(q * (1.0f / 1024.0f) + LN_EPS);
        h16x8 o0, o1;
#pragma unroll
        for (int k = 0; k < 8; ++k) { o0[k] = (h16)(a[k] * rstd * gg[k >> 2][k & 3] + bv[k >> 2][k & 3]); o1[k] = (h16)(a[8 + k] * rstd * gg[2 + (k >> 2)][k & 3] + bv[2 + (k >> 2)][k & 3]); }
        rp[0] = o0; rp[1] = o1;
    }
}

__device__ void phase_halo(const Params& P) {
    const h16* H = (const h16*)(P.ws + OFF_H); h16* HALO = (h16*)(P.ws + OFF_HALO);
    for (int blk = blockIdx.x; blk < 256; blk += gridDim.x) {
        const int r0 = blk * 128; const bool first = (r0 % L_) == 0;
        for (int i = threadIdx.x; i < 2 * 5632 / 2; i += blockDim.x) {
            const int rr = i / 2816, cc = (i % 2816) * 2;
            h16x2 v; v[0] = (h16)0.f; v[1] = (h16)0.f;
            if (!first) v = *(const h16x2*)(H + (size_t)(r0 - 2 + rr) * 5632 + cc);
            *(h16x2*)(HALO + ((size_t)blk * 2 + rr) * 5632 + cc) = v;
        }
    }
}

__device__ void phase_convact(const Params& P) {
    h16* H = (h16*)(P.ws + OFF_H); const h16* HALO = (const h16*)(P.ws + OFF_HALO);
    for (int blk = blockIdx.x; blk < 256; blk += gridDim.x) {
        const int r0 = blk * 128;
        const int cg8 = threadIdx.x;
        if (cg8 < 352) {
            const int c = 8 * cg8;
            float wg[3][8], wvv[3][8], bg[8], bvv[8];
#pragma unroll
            for (int j = 0; j < 3; ++j)
#pragma unroll
                for (int k = 0; k < 8; ++k) { wg[j][k] = P.conv_w[j * 5632 + c + k]; wvv[j][k] = P.conv_w[j * 5632 + 2816 + c + k]; }
#pragma unroll
            for (int k = 0; k < 8; ++k) { bg[k] = P.conv_b[c + k]; bvv[k] = P.conv_b[2816 + c + k]; }
            h16x8 g2, v2, g1, v1;
#pragma unroll
            for (int k = 0; k < 8; ++k) { g2[k] = (h16)0.f; v2[k] = (h16)0.f; g1[k] = (h16)0.f; v1[k] = (h16)0.f; }
            if ((r0 % L_) != 0) {
                g2 = *(const h16x8*)(HALO + ((size_t)blk * 2 + 0) * 5632 + c); v2 = *(const h16x8*)(HALO + ((size_t)blk * 2 + 0) * 5632 + 2816 + c);
                g1 = *(const h16x8*)(HALO + ((size_t)blk * 2 + 1) * 5632 + c); v1 = *(const h16x8*)(HALO + ((size_t)blk * 2 + 1) * 5632 + 2816 + c);
            }
            for (int rr = 0; rr < 128; rr += 4) {
                h16x8 gq[4], vq[4];
#pragma unroll
                for (int u = 0; u < 4; ++u) { const h16* rp = H + (size_t)(r0 + rr + u) * 5632; gq[u] = *(const h16x8*)(rp + c); vq[u] = *(const h16x8*)(rp + 2816 + c); }
#pragma unroll
                for (int u = 0; u < 4; ++u) {
                    h16x8 o;
#pragma unroll
                    for (int k = 0; k < 8; ++k) {
                        const float cgv = wg[2][k] * (float)gq[u][k] + wg[1][k] * (float)g1[k] + wg[0][k] * (float)g2[k] + bg[k];
                        const float cvv = wvv[2][k] * (float)vq[u][k] + wvv[1][k] * (float)v1[k] + wvv[0][k] * (float)v2[k] + bvv[k];
                        o[k] = (h16)(siluf_(cgv) * cvv);
                    }
                    *(h16x8*)(H + (size_t)(r0 + rr + u) * 5632 + c) = o;
                    g2 = g1; g1 = gq[u]; v2 = v1; v1 = vq[u];
                }
            }
        }
    }
}

__device__ __forceinline__ void run_phase(const Params& P, unsigned char* smem, const int ph) {
    unsigned char* ws = P.ws;
    switch (ph) {
#ifdef ONLY_PHASE
    case ONLY_PHASE + 100: break;
#endif
    case 0: phase_prep(P, smem); break;
    case 1: gm::run_gemm<0>(smem, (const h16*)(ws + OFF_X16), 1024, (const h16*)(ws + OFF_WIN), T_, 7936, 1024, (void*)P.out, nullptr, nullptr, 0, ws); break;
    case 2: phase_gla_prep(P, smem); break;
    case 3: phase_mixers(P, smem); break;
    case 4:
        cvt_f32_to_h16(P.p, (h16*)(ws + OFF_P16), (size_t)T_ * 256);
        gm::run_gemm<1>(smem, (const h16*)(ws + OFF_X16), 1024, (const h16*)(ws + OFF_WGLA), T_, 1024, 1024, (void*)(ws + OFF_MERGED), (const void*)P.out, nullptr, 1024, ws);
        gm::run_gemm<2>(smem, (const h16*)(ws + OFF_DQ), 2048, (const h16*)(ws + OFF_WCOMB), T_, 1024, 1024, (void*)(ws + OFF_MERGED), (const void*)P.out, nullptr, 1024, ws);
        break;
    case 5: gm::run_gemm<3>(smem, (const h16*)(ws + OFF_MERGED), 1024, (const h16*)(ws + OFF_WOUT), T_, 1024, 1024, (void*)(ws + OFF_X16), (const void*)P.x, nullptr, 1024, ws); break;
    case 6: ln_rows16((h16*)(ws + OFF_X16), P.ln1_g, P.ln1_b); break;
    case 7: gm::run_gemm<4>(smem, (const h16*)(ws + OFF_X16), 1024, (const h16*)(ws + OFF_WUP), T_, 5632, 1024, (void*)(ws + OFF_H), nullptr, nullptr, 5632, ws); break;
    case 9: phase_convact(P); break;
    case 10: gm::run_gemm<5>(smem, (const h16*)(ws + OFF_H), 5632, (const h16*)(ws + OFF_WDOWN), T_, 1024, 2816, (void*)(ws + OFF_X16), (const void*)(ws + OFF_X16), nullptr, 1024, ws); break;
    case 11: ln_rows16((h16*)(ws + OFF_X16), P.ln2_g, P.ln2_b); break;
    case 12:
        gm::run_gemm<6>(smem, (const h16*)(ws + OFF_X16), 1024, (const h16*)(ws + OFF_WPG), T_, 1024, 1024, (void*)(ws + OFF_G), nullptr, nullptr, 1024, ws);
        gm::run_gemm<7>(smem, (const h16*)(ws + OFF_P16), 256, (const h16*)(ws + OFF_WPLE), T_, 1024, 256, (void*)P.out, (const void*)(ws + OFF_X16), (const void*)(ws + OFF_G), 1024, ws);
        break;
    case 13: ln_rows(P.out, P.ln3_g, P.ln3_b, nullptr, P.out); break;
    default: break;
    }
}

__device__ __forceinline__ void fast_grid_sync(unsigned* ctr, unsigned target) {
    __syncthreads();
    if (threadIdx.x == 0) {
        __builtin_amdgcn_fence(__ATOMIC_RELEASE, "agent");
        __hip_atomic_fetch_add(ctr, 1u, __ATOMIC_RELAXED, __HIP_MEMORY_SCOPE_AGENT);
        while (__hip_atomic_load(ctr, __ATOMIC_RELAXED, __HIP_MEMORY_SCOPE_AGENT) < target) __builtin_amdgcn_s_sleep(1);
        __builtin_amdgcn_fence(__ATOMIC_ACQUIRE, "agent");
    }
    __syncthreads();
}

__global__ void __launch_bounds__(512, 2) fwd_megakernel(Params P) {
    extern __shared__ __attribute__((aligned(16))) unsigned char smem[];
    cg::grid_group grid = cg::this_grid();
    unsigned* gbar = (unsigned*)(P.ws + OFF_CTR + 4096); unsigned nbar = 0;
#define RUNPH(k) do { if (P.phase_lo <= (k) && (k) < P.phase_hi) run_phase(P, smem, (k)); \
        if (P.phase_lo <= (k) && (k) + 1 < P.phase_hi) { if ((k) == 0) grid.sync(); else { ++nbar; fast_grid_sync(gbar, nbar * gridDim.x); } } } while (0)
    RUNPH(0); RUNPH(1); RUNPH(2); RUNPH(3); RUNPH(4); RUNPH(5); RUNPH(6); RUNPH(7); RUNPH(9); RUNPH(10); RUNPH(11); RUNPH(12); RUNPH(13);
#undef RUNPH
}

extern "C" void kernel_launch(void* const* d_in, const int* in_sizes, int n_in, void* d_out, int out_size, void* d_ws, size_t ws_size, hipStream_t stream) {
    static int grid = 0;
    if (grid == 0) {
        if (n_in != 23 || ws_size < WS_NEED) { fprintf(stderr, "kernel_launch: need 23 inputs and >= %zu bytes of workspace; got %d, %zu\n", (size_t)WS_NEED, n_in, ws_size); grid = -1; return; }
        int dev = 0, cus = 0, per_cu = 0;
        hipGetDevice(&dev);
        hipDeviceGetAttribute(&cus, hipDeviceAttributeMultiprocessorCount, dev);
        if (hipFuncSetAttribute((const void*)fwd_megakernel, hipFuncAttributeMaxDynamicSharedMemorySize, SMEM_BYTES) != hipSuccess) { fprintf(stderr, "kernel_launch: hipFuncSetAttribute failed\n"); grid = -1; return; }
        if (hipOccupancyMaxActiveBlocksPerMultiprocessor(&per_cu, (const void*)fwd_megakernel, 512, SMEM_BYTES) != hipSuccess || per_cu < 1) { fprintf(stderr, "kernel_launch: occupancy query gives %d\n", per_cu); grid = -1; return; }
        (void)hipGetLastError();
        grid = cus;
    }
    if (grid < 0) return;
    Params p{};
    const float** pp = (const float**)&p;
    for (int i = 0; i < 23; ++i) pp[i] = (const float*)d_in[i];
    p.out = (float*)d_out; p.ws = (unsigned char*)d_ws; p.pad1 = PROBE_GLA_REP; p.pad0 = PROBE_SEL_REP;
#if MULTI_LAUNCH
    static const int seq[] = PROBE_SEQ;
    for (int i = 0; i < (int)(sizeof(seq) / sizeof(int)); ++i) {
        p.phase_lo = seq[i]; p.phase_hi = seq[i] + 1;
        hipLaunchKernelGGL(fwd_megakernel, dim3(grid), dim3(512), SMEM_BYTES, stream, p);
    }
#else
    hipMemsetAsync((unsigned char*)d_ws + OFF_CTR + 4096, 0, 256, stream);
    p.phase_lo = 0; p.phase_hi = NPHASE;
    void* args[] = {&p};
    hipError_t e = hipLaunchCooperativeKernel((const void*)fwd_megakernel, dim3(grid), dim3(512), args, SMEM_BYTES, stream);
    if (e != hipSuccess) fprintf(stderr, "cooperative launch failed: %s (grid %d)\n", hipGetErrorString(e), grid);
#endif
}
```
